# Optimizing an MI355X kernel written in HIP

```python
import jax, jax.numpy as jnp
from jax import lax
import numpy as np

D_MODEL = 1024
BATCH = 16
SEQ = 2048
DEPTH = 2

GRID_W = 64
CTX_LEN = 256
D_MIX = D_MODEL
D_CONF = D_MIX // 4
D_SC = D_MIX // 4
GLA_HEADS = 4
GLA_DK = D_MIX // 4 // GLA_HEADS
GLA_DV = D_MIX // 2 // GLA_HEADS
GLA_RANK = 16
GLA_TAU = 16.0
GLA_CHUNK = 32
CONF_K = 31
SC_K = 3
N_EXPERTS = 16
EC_FACTOR = 2
D_EXPERT = D_MODEL
EPS = 1e-6

CONF_IN = 2 * D_CONF
GLA_QK = GLA_HEADS * GLA_DK
GLA_V = GLA_HEADS * GLA_DV
SC_IN = 3 * D_SC
OFF_Q = CONF_IN
OFF_K = OFF_Q + GLA_QK
OFF_V = OFF_K + GLA_QK
OFF_AF = OFF_V + GLA_V
OFF_AB = OFF_AF + GLA_RANK
OFF_R = OFF_AB + GLA_RANK
OFF_SC = OFF_R + GLA_V
D_IN = OFF_SC + SC_IN
SPLITS = [OFF_Q, OFF_K, OFF_V, OFF_AF, OFF_AB, OFF_R, OFF_SC]

kernel_name = 'hybrid_conformer_gla_shortconv_ec_moe_dit'


def rmsnorm(x, w):
    xf = x.astype(jnp.float32)
    y = xf * lax.rsqrt(jnp.mean(xf * xf, axis=-1, keepdims=True) + EPS)
    return (y * w.astype(jnp.float32)).astype(x.dtype)


def layernorm(x, w, b):
    xf = x.astype(jnp.float32)
    mu = jnp.mean(xf, axis=-1, keepdims=True)
    var = jnp.mean(jnp.square(xf - mu), axis=-1, keepdims=True)
    y = (xf - mu) * lax.rsqrt(var + EPS)
    return (y * w.astype(jnp.float32) + b.astype(jnp.float32)).astype(x.dtype)


def modulate(h, shift, scale):
    return h * (1 + scale) + shift


def depthwise_conv(u, w, b):
    K, C = w.shape
    out = lax.conv_general_dilated(u, w[:, None, :].astype(u.dtype), window_strides=(1,),
                                   padding=[(K // 2, K // 2)],
                                   dimension_numbers=('NWC', 'WIO', 'NWC'),
                                   feature_group_count=C)
    return out + b.astype(u.dtype)


def conformer_conv(u, w, b, ln_w, ln_b, grid):
    a, gte = jnp.split(u, 2, axis=-1)
    z = a * jax.nn.sigmoid(gte)
    if grid:
        B, L, C = z.shape
        rows = L // GRID_W
        z = depthwise_conv(z.reshape(B * rows, GRID_W, C), w, b).reshape(B, L, C)
    else:
        z = depthwise_conv(z, w, b)
    return jax.nn.silu(layernorm(z, ln_w, ln_b))


def short_conv(u, w, b):
    bg, cg, xh = jnp.split(u, 3, axis=-1)
    return bg * depthwise_conv(cg * xh, w, b)


def gla_scan(q, k, v, log_a, s0):
    B, H, L, DK = k.shape
    DV = v.shape[-1]
    n = L // GLA_CHUNK
    chunk = lambda t: t.astype(jnp.float32).reshape(B, H, n, GLA_CHUNK, t.shape[-1])
    k_c, v_c, a_c = chunk(k), chunk(v), chunk(log_a)
    b = jnp.cumsum(a_c, axis=3)
    g = b[:, :, :, -1]
    u = jnp.einsum('bhnck,bhncv->bhnkv', k_c * jnp.exp(g[:, :, :, None] - b), v_c)

    def step(s, inp):
        g_n, u_n = inp
        return jnp.exp(g_n)[..., None] * s + u_n, s

    s_fin, s_prev = lax.scan(step, s0.astype(jnp.float32),
                             (jnp.moveaxis(g, 2, 0), jnp.moveaxis(u, 2, 0)))
    if q is None:
        return None, s_fin
    s_prev = jnp.moveaxis(s_prev, 0, 2)
    q_c = chunk(q) * jnp.exp(b)
    k_rel = k_c * jnp.exp(-b)
    scores = jnp.einsum('bhnik,bhnjk->bhnij', q_c, k_rel)
    lower_tri = jnp.tril(jnp.ones((GLA_CHUNK, GLA_CHUNK), dtype=bool))
    scores = jnp.where(lower_tri, scores, 0.0)
    o = (jnp.einsum('bhnij,bhnjv->bhniv', scores, v_c)
         + jnp.einsum('bhnik,bhnkv->bhniv', q_c, s_prev))
    return o.reshape(B, H, L, DV), s_fin


def gla_prepare(q, k, v, af, ab, wa_f, ba_f, wa_b, ba_b):
    B, L, _ = k.shape
    heads = lambda t: t.reshape(B, L, GLA_HEADS, -1).transpose(0, 2, 1, 3)
    decay = lambda z, w, bb: heads(jax.nn.log_sigmoid((z @ w + bb).astype(jnp.float32)) / GLA_TAU)
    qh = None if q is None else heads(q * GLA_DK ** -0.5)
    return qh, heads(k), heads(v), decay(af, wa_f, ba_f), decay(ab, wa_b, ba_b)


def gla_bidirectional(lat, ctx_in):
    flip = lambda t: None if t is None else jnp.flip(t, axis=2)
    ql, kl, vl, alf, alb = lat
    qc, kc, vc, acf, acb = ctx_in
    B, H, _, DK = kl.shape
    zeros = jnp.zeros((B, H, DK, vl.shape[-1]), jnp.float32)
    oc_f, sc_f = gla_scan(qc, kc, vc, acf, zeros)
    oc_b, sc_b = gla_scan(flip(qc), flip(kc), flip(vc), flip(acb), zeros)
    ol_f, _ = gla_scan(ql, kl, vl, alf, sc_f)
    ol_b, _ = gla_scan(flip(ql), flip(kl), flip(vl), flip(alb), sc_b)
    o_lat = ol_f + flip(ol_b)
    o_ctx = None if qc is None else oc_f + flip(oc_b)
    return o_lat, o_ctx


def gla_output(o, r, gn_w):
    B, H, L, DV = o.shape
    o = o.transpose(0, 2, 1, 3)
    o = o * lax.rsqrt(jnp.mean(o * o, axis=-1, keepdims=True) + EPS)
    o = o.reshape(B, L, H * DV) * gn_w.astype(jnp.float32)
    return (o * jax.nn.silu(r.astype(jnp.float32))).astype(r.dtype)


def token_mixer(h, hc, w_in, w_out, conf_dw_w, conf_dw_b, conf_ln_w, conf_ln_b,
                gla_wa_f, gla_ba_f, gla_wa_b, gla_ba_b, gla_gn_w, sc_w, sc_b, ctx_out):
    dec = (gla_wa_f, gla_ba_f, gla_wa_b, gla_ba_b)
    conf_u, q, k, v, af, ab, r, sc_u = jnp.split(h @ w_in, SPLITS, axis=-1)
    if ctx_out:
        c_conf_u, c_q, c_k, c_v, c_af, c_ab, c_r, c_sc_u = jnp.split(hc @ w_in, SPLITS, axis=-1)
    else:
        c_q = None
        c_k, c_v, c_af, c_ab = jnp.split(hc @ w_in[:, OFF_K:OFF_R],
                                         [OFF_V - OFF_K, OFF_AF - OFF_K, OFF_AB - OFF_K], axis=-1)
    o_lat, o_ctx = gla_bidirectional(gla_prepare(q, k, v, af, ab, *dec),
                                     gla_prepare(c_q, c_k, c_v, c_af, c_ab, *dec))
    y = jnp.concatenate([conformer_conv(conf_u, conf_dw_w, conf_dw_b, conf_ln_w, conf_ln_b, True),
                         gla_output(o_lat, r, gla_gn_w),
                         short_conv(sc_u, sc_w, sc_b)], axis=-1) @ w_out
    if not ctx_out:
        return y, None
    yc = jnp.concatenate([conformer_conv(c_conf_u, conf_dw_w, conf_dw_b, conf_ln_w, conf_ln_b, False),
                          gla_output(o_ctx, c_r, gla_gn_w),
                          short_conv(c_sc_u, sc_w, sc_b)], axis=-1) @ w_out
    return y, yc


def expert_choice_ffn(h, router_w, w1, w3, w2):
    B, L, D = h.shape
    cap = EC_FACTOR * L // N_EXPERTS
    aff = jax.nn.softmax(jnp.einsum('bld,de->ble', h, router_w).astype(jnp.float32), axis=-1)
    gate, idx = lax.top_k(jnp.swapaxes(aff, 1, 2), cap)
    bidx = jnp.arange(B)[:, None, None]
    xs = h[bidx, idx]
    hid = jax.nn.silu(jnp.einsum('becd,edf->becf', xs, w1)) * jnp.einsum('becd,edf->becf', xs, w3)
    y = jnp.einsum('becf,efd->becd', hid, w2) * gate[..., None].astype(h.dtype)
    return jnp.zeros_like(h).at[bidx, idx].add(y)


def setup_inputs(seed: int = 0) -> dict:
    key = jax.random.key(seed)
    ks = jax.random.split(key, 32)
    f32 = jnp.float32
    nrm = lambda k, shape, scale: jax.random.normal(k, shape, f32) * scale
    L = DEPTH
    return {
        'x': nrm(ks[0], (BATCH, SEQ, D_MODEL), 1.0),
        'c': nrm(ks[1], (BATCH, D_MODEL), 1.0),
        'ctx': nrm(ks[2], (BATCH, CTX_LEN, D_MODEL), 1.0),
        'c_ctx': nrm(ks[3], (D_MODEL,), 1.0),
        'ada_w': nrm(ks[4], (L, D_MODEL, 6 * D_MODEL), 0.5 * D_MODEL ** -0.5),
        'ada_b': nrm(ks[5], (L, 6 * D_MODEL), 0.02),
        'norm1_w': 1.0 + nrm(ks[6], (L, D_MODEL), 0.02),
        'norm2_w': 1.0 + nrm(ks[7], (L, D_MODEL), 0.02),
        'w_in': nrm(ks[8], (L, D_MODEL, D_IN), D_MODEL ** -0.5),
        'conf_dw_w': nrm(ks[9], (L, CONF_K, D_CONF), CONF_K ** -0.5),
        'conf_dw_b': nrm(ks[10], (L, D_CONF), 0.02),
        'conf_ln_w': 1.0 + nrm(ks[11], (L, D_CONF), 0.02),
        'conf_ln_b': nrm(ks[12], (L, D_CONF), 0.02),
        'gla_wa_f': nrm(ks[13], (L, GLA_RANK, GLA_QK), GLA_RANK ** -0.5),
        'gla_ba_f': nrm(ks[14], (L, GLA_QK), 0.02),
        'gla_wa_b': nrm(ks[15], (L, GLA_RANK, GLA_QK), GLA_RANK ** -0.5),
        'gla_ba_b': nrm(ks[16], (L, GLA_QK), 0.02),
        'gla_gn_w': 1.0 + nrm(ks[17], (L, GLA_V), 0.02),
        'sc_w': nrm(ks[18], (L, SC_K, D_SC), SC_K ** -0.5),
        'sc_b': nrm(ks[19], (L, D_SC), 0.02),
        'w_out': nrm(ks[20], (L, D_MIX, D_MODEL), D_MIX ** -0.5),
        'router_w': nrm(ks[21], (L, D_MODEL, N_EXPERTS), D_MODEL ** -0.5),
        'exp_w1': nrm(ks[22], (L, N_EXPERTS, D_MODEL, D_EXPERT), D_MODEL ** -0.5),
        'exp_w3': nrm(ks[23], (L, N_EXPERTS, D_MODEL, D_EXPERT), D_MODEL ** -0.5),
        'exp_w2': nrm(ks[24], (L, N_EXPERTS, D_EXPERT, D_MODEL), D_EXPERT ** -0.5),
        'final_norm_w': 1.0 + nrm(ks[25], (D_MODEL,), 0.02),
    }


def reference(x, c, ctx, c_ctx, ada_w, ada_b, norm1_w, norm2_w, w_in, conf_dw_w, conf_dw_b,
              conf_ln_w, conf_ln_b, gla_wa_f, gla_ba_f, gla_wa_b, gla_ba_b, gla_gn_w, sc_w, sc_b,
              w_out, router_w, exp_w1, exp_w3, exp_w2, final_norm_w):
    s_lat = jax.nn.silu(c)[:, None, :]
    s_ctx = jax.nn.silu(c_ctx)
    xc = ctx
    for i in range(DEPTH):
        last = i == DEPTH - 1
        m_lat = jnp.split(s_lat @ ada_w[i] + ada_b[i], 6, axis=-1)
        m_ctx = jnp.split(s_ctx @ ada_w[i] + ada_b[i], 6, axis=-1)
        h = modulate(rmsnorm(x, norm1_w[i]), m_lat[0], m_lat[1])
        hc = modulate(rmsnorm(xc, norm1_w[i]), m_ctx[0], m_ctx[1])
        y, yc = token_mixer(h, hc, w_in[i], w_out[i], conf_dw_w[i], conf_dw_b[i], conf_ln_w[i],
                            conf_ln_b[i], gla_wa_f[i], gla_ba_f[i], gla_wa_b[i], gla_ba_b[i],
                            gla_gn_w[i], sc_w[i], sc_b[i], not last)
        x = x + m_lat[2] * y
        h = modulate(rmsnorm(x, norm2_w[i]), m_lat[3], m_lat[4])
        x = x + m_lat[5] * expert_choice_ffn(h, router_w[i], exp_w1[i], exp_w3[i], exp_w2[i])
        if not last:
            xc = xc + m_ctx[2] * yc
            hc = modulate(rmsnorm(xc, norm2_w[i]), m_ctx[3], m_ctx[4])
            xc = xc + m_ctx[5] * expert_choice_ffn(hc, router_w[i], exp_w1[i], exp_w3[i], exp_w2[i])
    return rmsnorm(x, final_norm_w)
```

```cpp
#include <hip/hip_runtime.h>
#include <cstdio>
#include <cstdint>

#ifndef MK_N_LAUNCHES
#define MK_N_LAUNCHES 1
#endif

constexpr int NB_ = 16, L_ = 2048, LC_ = 256, D_ = 1024;
constexpr int NLAT = NB_ * L_, NCTX = NB_ * LC_, MT = NLAT + NCTX;
constexpr int DIN = 2848, NP = 3072, NE = 16;
constexpr int CAP_L = 256, CAP_C = 32, SLOTS = NB_ * CAP_L + NB_ * CAP_C;
constexpr float EPS = 1e-6f;
constexpr int PK = 0, PV = 256, PAF = 768, PAB = 784, PQ = 1024, PR = 1280, PCA = 1792, PCG = 2048, PSB = 2304, PSC = 2560, PSX = 2816;
constexpr int NPHASES = 20;
constexpr int N_LAUNCHES = MK_N_LAUNCHES;

constexpr size_t MiB = 1u << 20;
constexpr size_t WS_CTL = 0, CTL_ZERO_BYTES = 32768;
constexpr size_t WS_MOD = 1 * MiB;
constexpr size_t WS_AFF = 2 * MiB;
constexpr size_t WS_IDX = 5 * MiB;
constexpr size_t WS_GATE = 5 * MiB + 512 * 1024;
constexpr size_t WS_INV = 6 * MiB;
constexpr size_t WS_XC = 9 * MiB;
constexpr size_t WS_WB = 25 * MiB, WB_LAYER = 56 * MiB;
constexpr size_t WS_HN = 137 * MiB;
constexpr size_t WS_PROJ = 209 * MiB;
constexpr size_t WS_OGLA = 425 * MiB;
constexpr size_t WS_YMIX = 497 * MiB;
constexpr size_t WS_Y2 = 209 * MiB;
constexpr size_t WS_HID = 353 * MiB;
constexpr size_t WS_YO = 425 * MiB;
constexpr size_t WS_END = 569 * MiB;
constexpr int CW_BAR = 4096;

constexpr int NWAVES = 8;
constexpr int RING_BYTES = 131072;
constexpr int LDSCTL_OFF = RING_BYTES, MISC_OFF = LDSCTL_OFF + 320;
constexpr int LDS_BYTES = 147456;

#define GAS __attribute__((address_space(1)))
#define LAS __attribute__((address_space(3)))
typedef unsigned short bf16;
typedef unsigned v4u __attribute__((ext_vector_type(4)));
typedef unsigned v2u __attribute__((ext_vector_type(2)));
typedef float f32x4 __attribute__((ext_vector_type(4)));
typedef float f32x16 __attribute__((ext_vector_type(16)));
typedef GAS unsigned gu32;

__device__ __forceinline__ float bf2f(unsigned h) { return __uint_as_float(h << 16); }
__device__ __forceinline__ unsigned f2bf(float f) { unsigned u = __float_as_uint(f); return (u + 0x7fffu + ((u >> 16) & 1u)) >> 16; }
typedef float f32x2p_t __attribute__((ext_vector_type(2))); typedef __bf16 bf16x2p_t __attribute__((ext_vector_type(2)));
__device__ __forceinline__ unsigned pk2(float lo, float hi) { f32x2p_t v = {lo, hi}; bf16x2p_t b = __builtin_convertvector(v, bf16x2p_t); return __builtin_bit_cast(unsigned, b); }
__device__ __forceinline__ f32x4 unpack4(v2u w) { return (f32x4){__uint_as_float(w.x << 16), __uint_as_float(w.x & 0xffff0000u), __uint_as_float(w.y << 16), __uint_as_float(w.y & 0xffff0000u)}; }
__device__ __forceinline__ v2u pack4(f32x4 v) { v2u r; r.x = pk2(v.x, v.y); r.y = pk2(v.z, v.w); return r; }
__device__ __forceinline__ float wave_sum(float v) {
#pragma unroll
    for (int o = 1; o < 64; o <<= 1) v += __shfl_xor(v, o);
    return v;
}
__device__ __forceinline__ int wave_sum_i(int v) {
#pragma unroll
    for (int o = 1; o < 64; o <<= 1) v += __shfl_xor(v, o);
    return v;
}
__device__ __forceinline__ float sigm(float x) { return __builtin_amdgcn_rcpf(1.f + __builtin_amdgcn_exp2f(-1.4426950408889634f * x)); }
__device__ __forceinline__ float silu(float x) { return x * __builtin_amdgcn_rcpf(1.f + __builtin_amdgcn_exp2f(-1.4426950408889634f * x)); }

#define XB_TMO      128
#define XB_XCNT(j)  (256  + 64 * (j))
#define XB_XSUB(j)  (1280 + 64 * (j))
#define XB_XGEN(j)  (2304 + 64 * (j))
#define XB_TOP      3328
#define XB_TOPGEN   3392
#define XCD_BAR_WORDS 3456
#define XB_SPIN_CAP (1u << 18)
__device__ __forceinline__ unsigned xb_ld(unsigned* p)              { return __hip_atomic_load(p, __ATOMIC_RELAXED, __HIP_MEMORY_SCOPE_AGENT); }
__device__ __forceinline__ unsigned xb_add(unsigned* p, unsigned v) { return __hip_atomic_fetch_add(p, v, __ATOMIC_RELAXED, __HIP_MEMORY_SCOPE_AGENT); }
__device__ __forceinline__ unsigned xb_xcc_id() { return (unsigned)__builtin_amdgcn_s_getreg((3 << 11) | 20) & 0xFu; }
#define XB_SPIN(cond, bar) do { unsigned _sp = 0; while (cond) { __builtin_amdgcn_s_sleep(1); \
    if ((++_sp & 255u) == 0u) { if (xb_ld(&(bar)[XB_TMO])) break; if (_sp > XB_SPIN_CAP) { atomicAdd(&(bar)[XB_TMO], 1u); break; } } } } while (0)
struct XcdBarrier { unsigned* bar; unsigned x; volatile LAS unsigned* st; };
__device__ __forceinline__ XcdBarrier xcd_barrier_post(unsigned* bar, volatile LAS unsigned* st) {
    XcdBarrier b; b.bar = bar; b.x = xb_xcc_id(); b.st = st;
    if (threadIdx.x == 0) (void)xb_add(&bar[XB_XCNT(b.x)], 1u);
    return b;
}
__device__ __forceinline__ void xcd_barrier_complete(unsigned* bar, unsigned x, unsigned& nloc, unsigned& nx) {
    const unsigned G = gridDim.x * gridDim.y * gridDim.z;
    unsigned sum, cnt, mine, sp = 0u;
    for (;;) {
        sum = 0u; cnt = 0u; mine = 0u;
#pragma unroll
        for (unsigned j = 0; j < 16; ++j) { const unsigned c = xb_ld(&bar[XB_XCNT(j)]); sum += c; cnt += (c > 0u) ? 1u : 0u; mine = (j == x) ? c : mine; }
        if (sum == G) break;
        __builtin_amdgcn_s_sleep(1);
        if ((++sp & 255u) == 0u) { if (xb_ld(&bar[XB_TMO])) break; if (sp > XB_SPIN_CAP) { atomicAdd(&bar[XB_TMO], 1u); break; } }
    }
    nloc = mine > 0u ? mine : 1u; nx = cnt > 0u ? cnt : 1u;
}
__device__ __forceinline__ void xcd_barrier(const XcdBarrier& b) {
    asm volatile("s_waitcnt vmcnt(0)" ::: "memory");
    __syncthreads();
    if (threadIdx.x == 0) {
        unsigned* bar = b.bar;
        __builtin_amdgcn_s_waitcnt(0);
        unsigned nloc = b.st[0], nx = b.st[1];
        if (nloc == 0u) { xcd_barrier_complete(bar, b.x, nloc, nx); b.st[0] = nloc; b.st[1] = nx; }
        const unsigned old = xb_add(&bar[XB_XSUB(b.x)], 1u);
        const unsigned gen = old / nloc;
        if (old + 1u == (gen + 1u) * nloc) {
            __builtin_amdgcn_fence(__ATOMIC_RELEASE, "agent");
            asm volatile("s_waitcnt vmcnt(0)" ::: "memory");
            const unsigned og = xb_add(&bar[XB_TOP], 1u);
            const unsigned tg = og / nx;
            if (og + 1u == (tg + 1u) * nx) xb_add(&bar[XB_TOPGEN], 1u);
            else XB_SPIN(xb_ld(&bar[XB_TOPGEN]) == tg, bar);
            __builtin_amdgcn_fence(__ATOMIC_ACQUIRE, "agent");
            xb_add(&bar[XB_XGEN(b.x)], 1u);
            asm volatile("s_waitcnt vmcnt(0)" ::: "memory");
        } else {
            XB_SPIN(xb_ld(&bar[XB_XGEN(b.x)]) == gen, bar);
            __builtin_amdgcn_fence(__ATOMIC_ACQUIRE, "agent");
            asm volatile("s_waitcnt vmcnt(0)" ::: "memory");
        }
    }
    __syncthreads();
}

__device__ __forceinline__ unsigned pk4_fp8(float a, float b, float c, float d) {
    a = __builtin_amdgcn_fmed3f(a, -448.f, 448.f); b = __builtin_amdgcn_fmed3f(b, -448.f, 448.f); c = __builtin_amdgcn_fmed3f(c, -448.f, 448.f); d = __builtin_amdgcn_fmed3f(d, -448.f, 448.f);
    unsigned w = 0u;
    w = (unsigned)__builtin_amdgcn_cvt_pk_fp8_f32(a, b, (int)w, false);
    w = (unsigned)__builtin_amdgcn_cvt_pk_fp8_f32(c, d, (int)w, true);
    return w;
}
constexpr float W8_SCALE = 32.f, W8_INV = 1.f / 32.f;
constexpr float Y8_SCALE = 64.f, Y8_INV = 1.f / 64.f;
typedef float f32x2u_t __attribute__((ext_vector_type(2)));
__device__ __forceinline__ f32x4 unpack4_fp8(unsigned w) { const f32x2u_t a = __builtin_amdgcn_cvt_pk_f32_fp8((int)w, false), b = __builtin_amdgcn_cvt_pk_f32_fp8((int)w, true); return (f32x4){a.x, a.y, b.x, b.y}; }
__device__ __forceinline__ int otid() { int t = threadIdx.x; asm volatile("" : "+v"(t)); return t; }
struct Args { const float* in[26]; float* out; unsigned char* ws; int ph_lo, ph_hi, li, pad; };
struct Ctx {
    const LAS unsigned long long* tab;
    __device__ __forceinline__ unsigned long long get(int k) const {
        const unsigned long long v = tab[k];
        const unsigned lo = __builtin_amdgcn_readfirstlane((unsigned)v), hi = __builtin_amdgcn_readfirstlane((unsigned)(v >> 32));
        return ((unsigned long long)hi << 32) | lo;
    }
    __device__ __forceinline__ const float* in(int k) const { return (const float*)(const GAS float*)get(k); }
    __device__ __forceinline__ float* out() const { return (float*)(GAS float*)get(26); }
    __device__ __forceinline__ unsigned char* ws() const { return (unsigned char*)(GAS unsigned char*)get(27); }
};

__device__ __forceinline__ int ref_col(int c) {
    if (c < 256) return 768 + c;
    if (c < 768) return 1024 + (c - 256);
    if (c < 800) return 1536 + (c - 768);
    if (c < 1024) return -1;
    if (c < 1280) return 512 + (c - 1024);
    if (c < 1792) return 1568 + (c - 1280);
    if (c < 2304) return c - 1792;
    return 2080 + (c - 2304);
}

__device__ __forceinline__ void p_mod(const Ctx& a, LAS unsigned char* lds, int tid) {
    const int lane = tid & 63, wave = tid >> 6;
    LAS float* s = (LAS float*)lds;
    LAS float* red = (LAS float*)(lds + 69632);
    const float* c = a.in(1); const float* cc = a.in(3);
    float* MODp = (float*)(a.ws() + WS_MOD);
    const float* adaw = a.in(4); const float* adab = a.in(5);
    for (int i = tid; i < 17 * 1024; i += 512) { const float v = (i < 16 * 1024) ? c[i] : cc[i - 16 * 1024]; s[i] = v / (1.f + expf(-v)); }
    __syncthreads();
    for (int task = blockIdx.x; task < 192; task += gridDim.x) {
        const int l = task / 96, n0 = (task % 96) * 64;
        const float* W = adaw + (size_t)l * 1024 * 6144 + n0 + lane;
        float acc[17];
#pragma unroll
        for (int j = 0; j < 17; ++j) acc[j] = 0.f;
        const int k0 = wave * 128;
        for (int k = k0; k < k0 + 128; k += 4) {
            const float w0 = W[(size_t)(k + 0) * 6144], w1 = W[(size_t)(k + 1) * 6144], w2 = W[(size_t)(k + 2) * 6144], w3 = W[(size_t)(k + 3) * 6144];
#pragma unroll
            for (int j = 0; j < 17; ++j) { const f32x4 sv = *(const LAS f32x4*)(s + j * 1024 + k); acc[j] += sv.x * w0 + sv.y * w1 + sv.z * w2 + sv.w * w3; }
        }
#pragma unroll
        for (int j = 0; j < 17; ++j) red[(wave * 17 + j) * 64 + lane] = acc[j];
        __syncthreads();
        for (int i = tid; i < 17 * 64; i += 512) {
            const int j = i >> 6, n = i & 63; float t = 0.f;
#pragma unroll
            for (int w = 0; w < 8; ++w) t += red[(w * 17 + j) * 64 + n];
            MODp[(size_t)(l * 17 + j) * 6144 + n0 + n] = t + adab[l * 6144 + n0 + n];
        }
        __syncthreads();
    }
}

__device__ __forceinline__ void combine_row(f32x4 (&v)[4], int inv, const unsigned char* Y2, const bf16* yo, const float* m2, const float* m5, int lane) {
    f32x4 s[4];
#pragma unroll
    for (int q = 0; q < 4; ++q) s[q] = (f32x4){0.f, 0.f, 0.f, 0.f};
    unsigned mask = (unsigned)(__ballot(inv >= 0) & 0xffffull);
    do {
        const unsigned char* yp[4]; float wgt[4];
#pragma unroll
        for (int k = 0; k < 4; ++k) {
            const bool have = mask != 0u;
            const int e = have ? (int)__builtin_ctz(mask) : 0;
            const int slot = have ? __builtin_amdgcn_readlane(inv, e) : 0;
            yp[k] = Y2 + ((size_t)e * SLOTS + slot) * D_ + 4 * lane; wgt[k] = have ? Y8_INV : 0.f;
            mask &= mask - 1u;
        }
        unsigned ld[4][4];
#pragma unroll
        for (int k = 0; k < 4; ++k)
#pragma unroll
            for (int q = 0; q < 4; ++q) ld[k][q] = *(const unsigned*)(yp[k] + 256 * q);
#pragma unroll
        for (int k = 0; k < 4; ++k)
#pragma unroll
            for (int q = 0; q < 4; ++q) s[q] += unpack4_fp8(ld[k][q]) * wgt[k];
    } while (mask != 0u);
#pragma unroll
    for (int q = 0; q < 4; ++q) v[q] += (*(const f32x4*)(m2 + 256 * q)) * unpack4(*(const v2u*)(yo + 256 * q)) + (*(const f32x4*)(m5 + 256 * q)) * s[q];
}
__device__ __forceinline__ void p_norm1(const Ctx& a, int mode, int tid) {
    const int lane = tid & 63, wave = tid >> 6;
    const int gw = blockIdx.x * NWAVES + wave, NGW = gridDim.x * NWAVES;
    const int npairs = ((mode == 2) ? NLAT : MT) / 2;
    const float* MODp = (const float*)(a.ws() + WS_MOD);
    const int* INV = (const int*)(a.ws() + WS_INV);
    const unsigned char* Y2 = a.ws() + WS_Y2;
    bf16* HN = (bf16*)(a.ws() + WS_HN);
    const bf16* YOp = (const bf16*)(a.ws() + WS_YO);
    const float* xin = a.in(0); const float* cin = a.in(2); float* XCp = (float*)(a.ws() + WS_XC); float* OUTp = a.out();
    const float* fwp = a.in(25); const float* n1w = a.in(6);
    for (int pr = gw; pr < npairs; pr += NGW) {
        const int row = 2 * pr;
        const bool isctx = row >= NLAT;
        const int j = isctx ? 16 : (row >> 11);
        const float* src; float* dst = nullptr;
        if (mode != 0) dst = isctx ? XCp + (size_t)(row - NLAT) * D_ : OUTp + (size_t)row * D_;
        src = (mode == 2) ? dst : (isctx ? cin + (size_t)(row - NLAT) * D_ : xin + (size_t)row * D_);
        f32x4 v0[4], v1[4];
#pragma unroll
        for (int q = 0; q < 4; ++q) { v0[q] = *(const f32x4*)(src + 4 * lane + 256 * q); v1[q] = *(const f32x4*)(src + D_ + 4 * lane + 256 * q); }
        if (mode != 0) {
            const int lp = (mode == 1) ? 0 : 1;
            const int inv0 = (lane < 16) ? INV[(size_t)row * 16 + lane] : -1, inv1 = (lane < 16) ? INV[(size_t)(row + 1) * 16 + lane] : -1;
            const float* m5 = MODp + (size_t)(lp * 17 + j) * 6144 + 5120 + 4 * lane;
            const float* m2 = MODp + (size_t)(lp * 17 + j) * 6144 + 2048 + 4 * lane;
            const bf16* yo = YOp + (size_t)row * D_ + 4 * lane;
            combine_row(v0, inv0, Y2, yo, m2, m5, lane);
            combine_row(v1, inv1, Y2, yo + D_, m2, m5, lane);
            if (mode == 1) {
#pragma unroll
                for (int q = 0; q < 4; ++q) { *(f32x4*)(dst + 4 * lane + 256 * q) = v0[q]; *(f32x4*)(dst + D_ + 4 * lane + 256 * q) = v1[q]; }
            }
        }
        float ss0 = 0.f, ss1 = 0.f;
#pragma unroll
        for (int q = 0; q < 4; ++q) {
            ss0 += (v0[q].x * v0[q].x + v0[q].y * v0[q].y) + (v0[q].z * v0[q].z + v0[q].w * v0[q].w);
            ss1 += (v1[q].x * v1[q].x + v1[q].y * v1[q].y) + (v1[q].z * v1[q].z + v1[q].w * v1[q].w);
        }
        ss0 = wave_sum(ss0); ss1 = wave_sum(ss1);
        const float rstd0 = rsqrtf(ss0 * (1.f / D_) + EPS), rstd1 = rsqrtf(ss1 * (1.f / D_) + EPS);
        if (mode == 2) {
            const float* fw = fwp + 4 * lane;
#pragma unroll
            for (int q = 0; q < 4; ++q) { const f32x4 w = *(const f32x4*)(fw + 256 * q); *(f32x4*)(dst + 4 * lane + 256 * q) = v0[q] * rstd0 * w; *(f32x4*)(dst + D_ + 4 * lane + 256 * q) = v1[q] * rstd1 * w; }
        } else {
            const int l = (mode == 0) ? 0 : 1;
            const float* nw = n1w + l * D_ + 4 * lane;
            const float* sh = MODp + (size_t)(l * 17 + j) * 6144 + 4 * lane;
            const float* sc = sh + 1024;
#pragma unroll
            for (int q = 0; q < 4; ++q) {
                const f32x4 g = (*(const f32x4*)(nw + 256 * q)) * ((*(const f32x4*)(sc + 256 * q)) + 1.f), bsh = *(const f32x4*)(sh + 256 * q);
                *(v2u*)(HN + (size_t)row * D_ + 4 * lane + 256 * q) = pack4(v0[q] * rstd0 * g + bsh);
                *(v2u*)(HN + (size_t)(row + 1) * D_ + 4 * lane + 256 * q) = pack4(v1[q] * rstd1 * g + bsh);
            }
        }
    }
}

typedef __bf16 bf16x2d_t __attribute__((ext_vector_type(2)));
__device__ __forceinline__ float dot2bf(unsigned x, unsigned w, float acc) {
    return __builtin_amdgcn_fdot2_f32_bf16(__builtin_bit_cast(bf16x2d_t, x), __builtin_bit_cast(bf16x2d_t, w), acc, false);
}
__device__ __forceinline__ float reduce16(const float (&t)[16], int lane) {
    const bool b5 = lane & 32, b4 = lane & 16, b3 = lane & 8, b2 = lane & 4;
    float u[8], w[4], x[2];
#pragma unroll
    for (int e = 0; e < 8; ++e) { const float keep = b5 ? t[e + 8] : t[e], send = b5 ? t[e] : t[e + 8]; u[e] = keep + __shfl_xor(send, 32); }
#pragma unroll
    for (int e = 0; e < 4; ++e) { const float keep = b4 ? u[e + 4] : u[e], send = b4 ? u[e] : u[e + 4]; w[e] = keep + __shfl_xor(send, 16); }
#pragma unroll
    for (int e = 0; e < 2; ++e) { const float keep = b3 ? w[e + 2] : w[e], send = b3 ? w[e] : w[e + 2]; x[e] = keep + __shfl_xor(send, 8); }
    const float keep = b2 ? x[1] : x[0], send = b2 ? x[0] : x[1];
    float y = keep + __shfl_xor(send, 4);
    y += __shfl_xor(y, 2); y += __shfl_xor(y, 1);
    return y;
}
__device__ __forceinline__ void p_norm2(const Ctx& a, LAS unsigned char* lds, int layer, int tid) {
    const int lane = tid & 63, wave = tid >> 6;
    const int gw = blockIdx.x * NWAVES + wave, NGW = gridDim.x * NWAVES;
    const int npairs = ((layer == 0) ? MT : NLAT) / 2;
    const float* MODp = (const float*)(a.ws() + WS_MOD);
    unsigned char* HN8 = a.ws() + WS_HN;
    const bf16* YO = (const bf16*)(a.ws() + WS_YO);
    float* AFF = (float*)(a.ws() + WS_AFF);
    LAS unsigned char* rwB = lds;
    const float* rw = a.in(21) + (size_t)layer * D_ * NE;
    float* XCp = (float*)(a.ws() + WS_XC); float* OUTp = a.out(); const float* n2w = a.in(7);
    const float* xin = a.in(0); const float* cin = a.in(2);
    for (int i = tid; i < D_ * NE / 2; i += 512) {
        const int e = i & 15, k = 2 * (i >> 4), L = (k & 255) >> 2, q = k >> 8, c = k & 3;
        *(LAS float*)(rwB + (q >> 1) * 16384 + (e * 64 + L) * 16 + (q & 1) * 8 + c * 2) = __uint_as_float(pk2(rw[k * 16 + e], rw[(k + 1) * 16 + e])); }
    __syncthreads();
    for (int pr = gw; pr < npairs; pr += NGW) {
        const int row = 2 * pr;
        const bool isctx = row >= NLAT;
        const int j = isctx ? 16 : (row >> 11);
        const float* src = (layer == 0) ? (isctx ? cin + (size_t)(row - NLAT) * D_ : xin + (size_t)row * D_) : (isctx ? XCp + (size_t)(row - NLAT) * D_ : OUTp + (size_t)row * D_);
        const bf16* yp = YO + (size_t)row * D_ + 4 * lane;
        const float* m2 = MODp + (size_t)(layer * 17 + j) * 6144 + 2048 + 4 * lane;
        f32x4 v0[4], v1[4];
        float ss0 = 0.f, ss1 = 0.f;
#pragma unroll
        for (int q = 0; q < 4; ++q) {
            const f32x4 g2 = *(const f32x4*)(m2 + 256 * q);
            v0[q] = *(const f32x4*)(src + 4 * lane + 256 * q) + g2 * unpack4(*(const v2u*)(yp + 256 * q));
            v1[q] = *(const f32x4*)(src + D_ + 4 * lane + 256 * q) + g2 * unpack4(*(const v2u*)(yp + D_ + 256 * q));
            ss0 += (v0[q].x * v0[q].x + v0[q].y * v0[q].y) + (v0[q].z * v0[q].z + v0[q].w * v0[q].w);
            ss1 += (v1[q].x * v1[q].x + v1[q].y * v1[q].y) + (v1[q].z * v1[q].z + v1[q].w * v1[q].w);
        }
        ss0 = wave_sum(ss0); ss1 = wave_sum(ss1);
        const float rstd0 = rsqrtf(ss0 * (1.f / D_) + EPS), rstd1 = rsqrtf(ss1 * (1.f / D_) + EPS);
        const float* nw = n2w + layer * D_ + 4 * lane;
        const float* sh = MODp + (size_t)(layer * 17 + j) * 6144 + 3072 + 4 * lane;
        const float* sc = sh + 1024;
        unsigned hp0[8], hp1[8];
#pragma unroll
        for (int q = 0; q < 4; ++q) {
            const f32x4 g = (*(const f32x4*)(nw + 256 * q)) * ((*(const f32x4*)(sc + 256 * q)) + 1.f), bsh = *(const f32x4*)(sh + 256 * q);
            const f32x4 h0 = v0[q] * rstd0 * g + bsh, h1 = v1[q] * rstd1 * g + bsh;
            *(unsigned*)(HN8 + (size_t)row * D_ + 4 * lane + 256 * q) = pk4_fp8(h0.x, h0.y, h0.z, h0.w);
            *(unsigned*)(HN8 + (size_t)(row + 1) * D_ + 4 * lane + 256 * q) = pk4_fp8(h1.x, h1.y, h1.z, h1.w);
            hp0[2 * q] = pk2(h0.x, h0.y); hp0[2 * q + 1] = pk2(h0.z, h0.w); hp1[2 * q] = pk2(h1.x, h1.y); hp1[2 * q + 1] = pk2(h1.z, h1.w);
        }
        float t0[16], t1[16];
        const LAS unsigned char* rwp = rwB + lane * 16;
#pragma unroll
        for (int e = 0; e < 16; ++e) {
            if ((e & 3) == 0) { if (e == 0) asm volatile("" : "+v"(rwp)); else asm volatile("" : "+v"(rwp) : "v"(t0[e - 1]), "v"(t1[e - 1])); }
            const f32x4 waf = *(const LAS f32x4*)(rwp + e * 1024), wbf = *(const LAS f32x4*)(rwp + 16384 + e * 1024);
            float a0 = 0.f, a1 = 0.f, b0 = 0.f, b1 = 0.f;
            a0 = dot2bf(hp0[0], __float_as_uint(waf.x), a0); b0 = dot2bf(hp0[1], __float_as_uint(waf.y), b0); a0 = dot2bf(hp0[2], __float_as_uint(waf.z), a0); b0 = dot2bf(hp0[3], __float_as_uint(waf.w), b0);
            a0 = dot2bf(hp0[4], __float_as_uint(wbf.x), a0); b0 = dot2bf(hp0[5], __float_as_uint(wbf.y), b0); a0 = dot2bf(hp0[6], __float_as_uint(wbf.z), a0); b0 = dot2bf(hp0[7], __float_as_uint(wbf.w), b0);
            a1 = dot2bf(hp1[0], __float_as_uint(waf.x), a1); b1 = dot2bf(hp1[1], __float_as_uint(waf.y), b1); a1 = dot2bf(hp1[2], __float_as_uint(waf.z), a1); b1 = dot2bf(hp1[3], __float_as_uint(waf.w), b1);
            a1 = dot2bf(hp1[4], __float_as_uint(wbf.x), a1); b1 = dot2bf(hp1[5], __float_as_uint(wbf.y), b1); a1 = dot2bf(hp1[6], __float_as_uint(wbf.z), a1); b1 = dot2bf(hp1[7], __float_as_uint(wbf.w), b1);
            t0[e] = a0 + b0; t1[e] = a1 + b1;
        }
        const float l0 = reduce16(t0, lane), l1 = reduce16(t1, lane);
        float m0 = l0, m1 = l1;
#pragma unroll
        for (int o = 4; o < 64; o <<= 1) { m0 = fmaxf(m0, __shfl_xor(m0, o)); m1 = fmaxf(m1, __shfl_xor(m1, o)); }
        const float e0 = expf(l0 - m0), e1 = expf(l1 - m1);
        float s0 = e0, s1 = e1;
#pragma unroll
        for (int o = 4; o < 64; o <<= 1) { s0 += __shfl_xor(s0, o); s1 += __shfl_xor(s1, o); }
        if ((lane & 3) == 0) { AFF[(size_t)row * 16 + (lane >> 2)] = e0 / s0; AFF[(size_t)(row + 1) * 16 + (lane >> 2)] = e1 / s1; }
    }
}

__device__ __forceinline__ int block_excl_scan(int val, LAS unsigned* tmp, int lane, int wave, int& total) {
    int inc = val;
#pragma unroll
    for (int d = 1; d < 64; d <<= 1) { const int t = __shfl_up(inc, d); if (lane >= d) inc += t; }
    if (lane == 63) tmp[wave] = (unsigned)inc;
    __syncthreads();
    int woff = 0, tot = 0;
#pragma unroll
    for (int w = 0; w < 8; ++w) { const int x = (int)tmp[w]; woff += (w < wave) ? x : 0; tot += x; }
    __syncthreads();
    total = tot;
    return woff + inc - val;
}
__device__ __forceinline__ void topk_task(const Ctx& a, LAS unsigned char* lds, int b, int e, bool isctx, int tid) {
    const int lane = tid & 63, wave = tid >> 6;
    const int Lr = isctx ? LC_ : L_, cap = isctx ? CAP_C : CAP_L;
    const int row0 = isctx ? NLAT + b * LC_ : b * L_;
    const int slot0 = isctx ? NB_ * CAP_L + b * CAP_C : b * CAP_L;
    LAS unsigned* wsum = (LAS unsigned*)lds;
    LAS unsigned* tmp = wsum + 16;
    const float* AFF = (const float*)(a.ws() + WS_AFF);
    int* IDX = (int*)(a.ws() + WS_IDX); float* GATE = (float*)(a.ws() + WS_GATE); int* INV = (int*)(a.ws() + WS_INV);
    unsigned key[4];
#pragma unroll
    for (int i = 0; i < 4; ++i) { const int t = 4 * tid + i; key[i] = (t < Lr) ? __float_as_uint(AFF[(size_t)(row0 + t) * 16 + e]) : 0u; }
    unsigned T = 0u;
    for (int bit = 30; bit >= 0; --bit) {
        const unsigned cand = T | (1u << bit);
        int c = (key[0] >= cand) + (key[1] >= cand) + (key[2] >= cand) + (key[3] >= cand);
        c = wave_sum_i(c);
        if (lane == 0) wsum[(bit & 1) * 8 + wave] = (unsigned)c;
        __syncthreads();
        unsigned tot = 0;
#pragma unroll
        for (int w = 0; w < 8; ++w) tot += wsum[(bit & 1) * 8 + w];
        if (tot >= (unsigned)cap) T = cand;
    }
    __syncthreads();
    const int ngt_mine = (key[0] > T) + (key[1] > T) + (key[2] > T) + (key[3] > T);
    const int neq_mine = (key[0] == T) + (key[1] == T) + (key[2] == T) + (key[3] == T);
    int ngt_tot, neq_tot;
    (void)block_excl_scan(ngt_mine, tmp, lane, wave, ngt_tot);
    int eqrank = block_excl_scan(neq_mine, tmp, lane, wave, neq_tot);
    const int need_eq = cap - ngt_tot;
    bool sel[4]; int nsel = 0;
#pragma unroll
    for (int i = 0; i < 4; ++i) {
        const bool eq = key[i] == T;
        sel[i] = (key[i] > T) || (eq && eqrank < need_eq);
        eqrank += eq ? 1 : 0; nsel += sel[i] ? 1 : 0;
    }
    int seltot;
    int slot = block_excl_scan(nsel, tmp, lane, wave, seltot);
#pragma unroll
    for (int i = 0; i < 4; ++i) {
        const int t = 4 * tid + i;
        if (t < Lr) {
            const int row = row0 + t;
            if (sel[i]) {
                IDX[e * SLOTS + slot0 + slot] = row; GATE[e * SLOTS + slot0 + slot] = __uint_as_float(key[i]);
                INV[(size_t)row * 16 + e] = slot0 + slot; ++slot;
            } else INV[(size_t)row * 16 + e] = -1;
        }
    }
    __syncthreads();
}
__device__ __forceinline__ void p_topk(const Ctx& a, LAS unsigned char* lds, int layer, int tid) {
    const int ntask = (layer == 0) ? 512 : 256;
    for (int t = blockIdx.x; t < ntask; t += gridDim.x) {
        const bool isctx = t >= 256; const int u = t & 255;
        topk_task(a, lds, u >> 4, u & 15, isctx, tid);
    }
}

__device__ __forceinline__ void unpack8(v4u w, float (&o)[8]) {
    o[0] = bf2f(w.x & 0xffffu); o[1] = bf2f(w.x >> 16); o[2] = bf2f(w.y & 0xffffu); o[3] = bf2f(w.y >> 16);
    o[4] = bf2f(w.z & 0xffffu); o[5] = bf2f(w.z >> 16); o[6] = bf2f(w.w & 0xffffu); o[7] = bf2f(w.w >> 16);
}
__device__ __forceinline__ void p_shortconv(const Ctx& a, int layer, int tid, int bidx, int nblk) {
    const bf16* PROJ = (const bf16*)(a.ws() + WS_PROJ); bf16* YM = (bf16*)(a.ws() + WS_YMIX);
    const int nrows = (layer == 0) ? MT : NLAT;
    const float* w = a.in(18) + layer * 3 * 256; const float* bb = a.in(19) + layer * 256;
    for (int i = bidx * 512 + tid; i < (nrows / 8) * 32; i += nblk * 512) {
        const int row0 = (i >> 5) * 8, cg = i & 31;
        const bool isctx = row0 >= NLAT;
        const int t0 = isctx ? ((row0 - NLAT) & (LC_ - 1)) : (row0 & (L_ - 1)); const int Lr = isctx ? LC_ : L_;
        const bf16* p = PROJ + (size_t)row0 * NP + cg * 8;
        v4u c4[10], x4[10], b4[8];
#pragma unroll
        for (int d = 0; d < 10; ++d) {
            const int tt = t0 + d - 1; const bool ok = (tt >= 0 && tt < Lr);
            c4[d] = ok ? *(const v4u*)(p + (ptrdiff_t)(d - 1) * NP + PSC) : (v4u){0u, 0u, 0u, 0u};
            x4[d] = ok ? *(const v4u*)(p + (ptrdiff_t)(d - 1) * NP + PSX) : (v4u){0u, 0u, 0u, 0u};
        }
#pragma unroll
        for (int d = 0; d < 8; ++d) b4[d] = *(const v4u*)(p + (size_t)d * NP + PSB);
        float w0[8], w1[8], w2[8], bv[8];
#pragma unroll
        for (int q = 0; q < 8; ++q) { w0[q] = w[cg * 8 + q]; w1[q] = w[256 + cg * 8 + q]; w2[q] = w[512 + cg * 8 + q]; bv[q] = bb[cg * 8 + q]; }
        float up[8], uc[8], un[8];
        { float cf[8], xf[8]; unpack8(c4[0], cf); unpack8(x4[0], xf);
#pragma unroll
          for (int q = 0; q < 8; ++q) up[q] = cf[q] * xf[q];
          unpack8(c4[1], cf); unpack8(x4[1], xf);
#pragma unroll
          for (int q = 0; q < 8; ++q) uc[q] = cf[q] * xf[q]; }
#pragma unroll
        for (int d = 0; d < 8; ++d) {
            float cf[8], xf[8], bg[8], o[8];
            unpack8(c4[d + 2], cf); unpack8(x4[d + 2], xf); unpack8(b4[d], bg);
#pragma unroll
            for (int q = 0; q < 8; ++q) { un[q] = cf[q] * xf[q]; o[q] = bg[q] * (w0[q] * up[q] + w1[q] * uc[q] + w2[q] * un[q] + bv[q]); up[q] = uc[q]; uc[q] = un[q]; }
            v4u r; r.x = pk2(o[0], o[1]); r.y = pk2(o[2], o[3]); r.z = pk2(o[4], o[5]); r.w = pk2(o[6], o[7]);
            *(v4u*)(YM + (size_t)(row0 + d) * D_ + 768 + cg * 8) = r;
        }
    }
}
__device__ __forceinline__ void conf_tile(const Ctx& a, LAS unsigned char* lds, int layer, int tile, int tid) {
    const int lane = tid & 63, wave = tid >> 6;
    const bf16* PROJ = (const bf16*)(a.ws() + WS_PROJ); bf16* YM = (bf16*)(a.ws() + WS_YMIX);
    bool isctx; int r0, t0;
    if (tile < 512) { isctx = false; r0 = (tile >> 5) * L_ + (tile & 31) * 64; t0 = 0; }
    else { const int u = tile - 512; isctx = true; t0 = (u & 3) * 64; r0 = NLAT + (u >> 2) * LC_ + t0; }
    LAS float* zt = (LAS float*)lds;
    __syncthreads();
    {
        v4u a4[6], g4[6];
#pragma unroll
        for (int it = 0; it < 6; ++it) {
            const int i = tid + 512 * it; const int idx = i >> 5, cg = i & 31, rel = idx - 15;
            const bool valid = (i < 94 * 32) && (isctx ? (t0 + rel >= 0 && t0 + rel < LC_) : (rel >= 0 && rel < 64));
            const bf16* p = PROJ + (size_t)(r0 + rel) * NP + cg * 8;
            a4[it] = valid ? *(const v4u*)(p + PCA) : (v4u){0u, 0u, 0u, 0u};
            g4[it] = valid ? *(const v4u*)(p + PCG) : (v4u){0u, 0u, 0u, 0u};
        }
#pragma unroll
        for (int it = 0; it < 6; ++it) {
            const int i = tid + 512 * it; const int idx = i >> 5, cg = i & 31;
            if (i < 94 * 32) {
                float af[8], gf[8]; unpack8(a4[it], af); unpack8(g4[it], gf);
                float z[8];
#pragma unroll
                for (int q = 0; q < 8; ++q) z[q] = af[q] * sigm(gf[q]);
                *(LAS f32x4*)(zt + idx * 256 + cg * 8) = (f32x4){z[0], z[1], z[2], z[3]};
                *(LAS f32x4*)(zt + idx * 256 + cg * 8 + 4) = (f32x4){z[4], z[5], z[6], z[7]};
            }
        }
    }
    __syncthreads();
    const int c = tid & 255, half = tid >> 8;
    float w[31];
    const float* cw = a.in(9) + (size_t)layer * 31 * 256 + c;
#pragma unroll
    for (int j = 0; j < 31; ++j) w[j] = cw[j * 256];
    const float bias = a.in(10)[layer * 256 + c];
    float out[32];
#pragma unroll
    for (int g4 = 0; g4 < 8; ++g4) {
        float win[34];
#pragma unroll
        for (int q = 0; q < 34; ++q) win[q] = zt[(half * 32 + g4 * 4 + q) * 256 + c];
#pragma unroll
        for (int u = 0; u < 4; ++u) {
            float acc = bias;
#pragma unroll
            for (int j = 0; j < 31; ++j) acc += w[j] * win[u + j];
            out[g4 * 4 + u] = acc;
        }
    }
    __syncthreads();
#pragma unroll
    for (int tt = 0; tt < 32; ++tt) zt[(half * 32 + tt) * 256 + c] = out[tt];
    __syncthreads();
    const f32x4 lw = *(const f32x4*)(a.in(11) + layer * 256 + 4 * lane), lb = *(const f32x4*)(a.in(12) + layer * 256 + 4 * lane);
    {
        f32x4 x[8]; float s1[8], s2[8];
#pragma unroll
        for (int i = 0; i < 8; ++i) { x[i] = *(const LAS f32x4*)(zt + (wave + 8 * i) * 256 + 4 * lane); s1[i] = (x[i].x + x[i].y) + (x[i].z + x[i].w); s2[i] = (x[i].x * x[i].x + x[i].y * x[i].y) + (x[i].z * x[i].z + x[i].w * x[i].w); }
#pragma unroll
        for (int o = 1; o < 64; o <<= 1)
#pragma unroll
            for (int i = 0; i < 8; ++i) { s1[i] += __shfl_xor(s1[i], o); s2[i] += __shfl_xor(s2[i], o); }
#pragma unroll
        for (int i = 0; i < 8; ++i) {
            const float mean = s1[i] * (1.f / 256.f); const float var = fmaxf(s2[i] * (1.f / 256.f) - mean * mean, 0.f);
            const f32x4 y = (x[i] - mean) * rsqrtf(var + EPS) * lw + lb;
            const f32x4 o = (f32x4){silu(y.x), silu(y.y), silu(y.z), silu(y.w)};
            *(v2u*)(YM + (size_t)(r0 + wave + 8 * i) * D_ + 4 * lane) = pack4(o);
        }
    }
}
#define ZERO16 (f32x16){0.f,0.f,0.f,0.f,0.f,0.f,0.f,0.f,0.f,0.f,0.f,0.f,0.f,0.f,0.f,0.f}
typedef short s16x8 __attribute__((ext_vector_type(8)));
constexpr int GL_QD = 0, GL_KD = 4608, GL_FR = 9216, GL_EG = 13312, GL_SLOT = 13824;
typedef float f32x2_t __attribute__((ext_vector_type(2))); typedef __bf16 bf16x2_t __attribute__((ext_vector_type(2)));
__device__ __forceinline__ unsigned cvtpk(float lo, float hi) { f32x2_t v = {lo, hi}; bf16x2_t b = __builtin_convertvector(v, bf16x2_t); return __builtin_bit_cast(unsigned, b); }
__device__ __forceinline__ s16x8 pack8(const f32x16& x, int s) {
    v4u w; w.x = cvtpk(x[8 * s + 0], x[8 * s + 1]); w.y = cvtpk(x[8 * s + 2], x[8 * s + 3]); w.z = cvtpk(x[8 * s + 4], x[8 * s + 5]); w.w = cvtpk(x[8 * s + 6], x[8 * s + 7]);
    return __builtin_bit_cast(s16x8, w);
}
#define GL_BAR() do { asm volatile("s_waitcnt lgkmcnt(0)" ::: "memory"); __builtin_amdgcn_s_barrier(); asm volatile("" ::: "memory"); } while (0)
__device__ __forceinline__ int gla_row0(int b, int dir, int c) {
    return (c < 8) ? (NLAT + b * LC_ + (dir ? (LC_ - 1 - 32 * c) : 32 * c)) : (b * L_ + (dir ? (L_ - 1 - 32 * (c - 8)) : 32 * (c - 8)));
}
__device__ __forceinline__ void gla_fast_task(const Ctx& a, LAS unsigned char* lds, int layer, int task, int tid) {
    const int dir = task & 1, h = (task >> 1) & 3, b = task >> 3;
    const int lane = tid & 63, wave = __builtin_amdgcn_readfirstlane(tid >> 6);
    const int n = lane & 31, hh = lane >> 5;
    const bf16* PROJ = (const bf16*)(a.ws() + WS_PROJ);
    const int sgn = dir ? -1 : 1;
    __syncthreads();
    if (wave < 4) {
        const int cc = wave >> 1, dt = wave & 1;
        const int dkl = 32 * dt + n;
        const float* wa = a.in(dir ? 15 : 13) + layer * 16 * 256 + h * 64 + dkl;
        const float bav = a.in(dir ? 16 : 14)[layer * 256 + h * 64 + dkl];
        const int afoff = dir ? PAB : PAF;
        s16x8 wah, wal;
        {
            float wv[8]; unsigned hi[8], lo[8];
#pragma unroll
            for (int j = 0; j < 8; ++j) { wv[j] = wa[(8 * hh + j) * 256]; hi[j] = f2bf(wv[j]); lo[j] = f2bf(wv[j] - bf2f(hi[j])); }
            v4u wh, wl;
            wh.x = hi[0] | (hi[1] << 16); wh.y = hi[2] | (hi[3] << 16); wh.z = hi[4] | (hi[5] << 16); wh.w = hi[6] | (hi[7] << 16);
            wl.x = lo[0] | (lo[1] << 16); wl.y = lo[2] | (lo[3] << 16); wl.z = lo[4] | (lo[5] << 16); wl.w = lo[6] | (lo[7] << 16);
            wah = __builtin_bit_cast(s16x8, wh); wal = __builtin_bit_cast(s16x8, wl);
        }
        v4u afr_n; unsigned qr_n[16], kr_n[16];
        const char* Pb = (const char*)PROJ;
        const int afl = (sgn * n * NP + afoff + 8 * hh) * 2, ql = (sgn * 4 * hh * NP + PQ + h * 64 + dkl) * 2, kl = (sgn * 4 * hh * NP + PK + h * 64 + dkl) * 2;
        {
            const char* prow = Pb + (size_t)gla_row0(b, dir, cc) * (NP * 2);
            afr_n = *(const v4u*)(prow + afl);
#pragma unroll
            for (int r = 0; r < 16; ++r) { const int ro = sgn * ((r & 3) + 8 * (r >> 2)) * (NP * 2); qr_n[r] = *(const bf16*)(prow + (ql + ro)); kr_n[r] = *(const bf16*)(prow + (kl + ro)); }
        }
        for (int i = 0; i <= 36; ++i) {
            if (i < 36) {
                LAS unsigned char* sl = lds + ((i & 1) * 2 + cc) * GL_SLOT;
                const v4u afr = afr_n; unsigned qr[16], kr[16];
#pragma unroll
                for (int r = 0; r < 16; ++r) { qr[r] = qr_n[r]; kr[r] = kr_n[r]; }
                if (i + 1 < 36) {
                    const char* prow = Pb + (size_t)gla_row0(b, dir, 2 * (i + 1) + cc) * (NP * 2);
                    afr_n = *(const v4u*)(prow + afl);
#pragma unroll
                    for (int r = 0; r < 16; ++r) { const int ro = sgn * ((r & 3) + 8 * (r >> 2)) * (NP * 2); qr_n[r] = *(const bf16*)(prow + (ql + ro)); kr_n[r] = *(const bf16*)(prow + (kl + ro)); }
                }
                f32x16 Z = ZERO16;
                Z = __builtin_amdgcn_mfma_f32_32x32x16_bf16(__builtin_bit_cast(s16x8, afr), wah, Z, 0, 0, 0);
                Z = __builtin_amdgcn_mfma_f32_32x32x16_bf16(__builtin_bit_cast(s16x8, afr), wal, Z, 0, 0, 0);
                float p[16];
#pragma unroll
                for (int r = 0; r < 16; ++r) { const float z = Z[r] + bav; p[r] = fminf(z, 0.f) * (1.f / 16.f) - __builtin_amdgcn_logf(1.f + __builtin_amdgcn_exp2f(-1.4426950408889634f * fabsf(z))) * (0.6931471805599453f / 16.f); }
                float G[4], Gp[4];
#pragma unroll
                for (int g = 0; g < 4; ++g) { p[4 * g + 1] += p[4 * g]; p[4 * g + 2] += p[4 * g + 1]; p[4 * g + 3] += p[4 * g + 2]; G[g] = p[4 * g + 3]; }
#pragma unroll
                for (int g = 0; g < 4; ++g) Gp[g] = __shfl_xor(G[g], 32);
                float off = 0.f;
#pragma unroll
                for (int g = 0; g < 4; ++g) {
                    const float o_g = off + (hh ? Gp[g] : 0.f);
#pragma unroll
                    for (int q = 0; q < 4; ++q) p[4 * g + q] += o_g;
                    off += G[g] + Gp[g];
                }
                f32x16 kd;
#pragma unroll
                for (int r = 0; r < 16; ++r) {
                    const int t = (r & 3) + 8 * (r >> 2) + 4 * hh;
                    const float E = __builtin_amdgcn_exp2f(p[r] * 1.4426950408889634f);
                    const float qd = bf2f(qr[r]) * 0.125f * E; const float kdv = bf2f(kr[r]) * __builtin_amdgcn_rcpf(E);
                    kd[r] = kdv;
                    const unsigned qk = cvtpk(qd, kdv);
                    *(LAS unsigned short*)(sl + GL_QD + t * 144 + dkl * 2) = (unsigned short)(qk & 0xffffu);
                    *(LAS unsigned short*)(sl + GL_KD + t * 144 + dkl * 2) = (unsigned short)(qk >> 16);
                }
                *(LAS s16x8*)(sl + GL_FR + ((dt * 2 + 0) * 64 + lane) * 16) = pack8(kd, 0);
                *(LAS s16x8*)(sl + GL_FR + ((dt * 2 + 1) * 64 + lane) * 16) = pack8(kd, 1);
                if (hh == 0) *(LAS float*)(sl + GL_EG + dkl * 4) = __builtin_amdgcn_exp2f(off * 1.4426950408889634f);
            }
            GL_BAR();
        }
    } else {
        const int n0 = 32 * (wave - 4);
        const char* Vb = (const char*)(PROJ + PV + h * 128 + n0);
        char* Ob = (char*)((bf16*)(a.ws() + WS_OGLA) + (size_t)dir * MT * 512 + h * 128 + n0);
        const int vl = (sgn * 4 * hh * NP + n) * 2, ol = (sgn * 4 * hh * 512 + n) * 2;
        f32x16 S0 = ZERO16, S1 = ZERO16;
        unsigned vr_n[2][16];
#pragma unroll
        for (int cc = 0; cc < 2; ++cc)
#pragma unroll
            for (int r = 0; r < 16; ++r) vr_n[cc][r] = 0u;
        for (int i = 0; i <= 36; ++i) {
            unsigned vr[2][16];
#pragma unroll
            for (int cc = 0; cc < 2; ++cc)
#pragma unroll
                for (int r = 0; r < 16; ++r) vr[cc][r] = vr_n[cc][r];
            if (i < 36) {
#pragma unroll
                for (int cc = 0; cc < 2; ++cc) {
                    const char* vrow = Vb + (size_t)gla_row0(b, dir, 2 * i + cc) * (NP * 2);
#pragma unroll
                    for (int r = 0; r < 16; ++r) vr_n[cc][r] = *(const bf16*)(vrow + (vl + sgn * ((r & 3) + 8 * (r >> 2)) * (NP * 2)));
                }
            }
            if (i >= 1) {
                const LAS unsigned char* slb = lds + ((i - 1) & 1) * 2 * GL_SLOT;
                s16x8 vb[2][2];
#pragma unroll
                for (int cc = 0; cc < 2; ++cc)
#pragma unroll
                    for (int s2 = 0; s2 < 2; ++s2) {
                        v4u w; w.x = vr[cc][8 * s2 + 0] | (vr[cc][8 * s2 + 1] << 16); w.y = vr[cc][8 * s2 + 2] | (vr[cc][8 * s2 + 3] << 16);
                        w.z = vr[cc][8 * s2 + 4] | (vr[cc][8 * s2 + 5] << 16); w.w = vr[cc][8 * s2 + 6] | (vr[cc][8 * s2 + 7] << 16);
                        vb[cc][s2] = __builtin_bit_cast(s16x8, w);
                    }
                f32x16 o[2];
#pragma unroll
                for (int cc = 0; cc < 2; ++cc) {
                    const LAS unsigned char* sl = slb + cc * GL_SLOT;
                    f32x16 PT = ZERO16;
#pragma unroll
                    for (int s4 = 0; s4 < 4; ++s4) {
                        const s16x8 ak = *(const LAS s16x8*)(sl + GL_KD + n * 144 + (16 * s4 + 8 * hh) * 2);
                        const s16x8 bq = *(const LAS s16x8*)(sl + GL_QD + n * 144 + (16 * s4 + 8 * hh) * 2);
                        PT = __builtin_amdgcn_mfma_f32_32x32x16_bf16(ak, bq, PT, 0, 0, 0);
                    }
#pragma unroll
                    for (int r = 0; r < 16; ++r) { const int j = (r & 3) + 8 * (r >> 2) + 4 * hh; PT[r] = (j <= n) ? PT[r] : 0.f; }
                    o[cc] = ZERO16;
                    o[cc] = __builtin_amdgcn_mfma_f32_32x32x16_bf16(pack8(PT, 0), vb[cc][0], o[cc], 0, 0, 0);
                    o[cc] = __builtin_amdgcn_mfma_f32_32x32x16_bf16(pack8(PT, 1), vb[cc][1], o[cc], 0, 0, 0);
                }
#pragma unroll
                for (int cc = 0; cc < 2; ++cc) {
                    const int c = 2 * (i - 1) + cc;
                    const LAS unsigned char* sl = slb + cc * GL_SLOT;
                    f32x16 d0 = ZERO16, d1 = ZERO16;
#pragma unroll
                    for (int s2 = 0; s2 < 2; ++s2) {
                        d0 = __builtin_amdgcn_mfma_f32_32x32x16_bf16(*(const LAS s16x8*)(sl + GL_FR + ((0 * 2 + s2) * 64 + lane) * 16), vb[cc][s2], d0, 0, 0, 0);
                        d1 = __builtin_amdgcn_mfma_f32_32x32x16_bf16(*(const LAS s16x8*)(sl + GL_FR + ((1 * 2 + s2) * 64 + lane) * 16), vb[cc][s2], d1, 0, 0, 0);
                    }
#pragma unroll
                    for (int dt = 0; dt < 2; ++dt)
#pragma unroll
                        for (int s2 = 0; s2 < 2; ++s2) {
                            const v2u a0 = *(const LAS v2u*)(sl + GL_QD + n * 144 + (32 * dt + 16 * s2 + 4 * hh) * 2);
                            const v2u a1 = *(const LAS v2u*)(sl + GL_QD + n * 144 + (32 * dt + 16 * s2 + 8 + 4 * hh) * 2);
                            const v4u aw = (v4u){a0.x, a0.y, a1.x, a1.y};
                            o[cc] = __builtin_amdgcn_mfma_f32_32x32x16_bf16(__builtin_bit_cast(s16x8, aw), pack8(dt ? S1 : S0, s2), o[cc], 0, 0, 0);
                        }
#pragma unroll
                    for (int g = 0; g < 4; ++g) {
                        const f32x4 e0 = *(const LAS f32x4*)(sl + GL_EG + (8 * g + 4 * hh) * 4), e1 = *(const LAS f32x4*)(sl + GL_EG + (32 + 8 * g + 4 * hh) * 4);
                        S0[4 * g + 0] = e0.x * (S0[4 * g + 0] + d0[4 * g + 0]); S0[4 * g + 1] = e0.y * (S0[4 * g + 1] + d0[4 * g + 1]);
                        S0[4 * g + 2] = e0.z * (S0[4 * g + 2] + d0[4 * g + 2]); S0[4 * g + 3] = e0.w * (S0[4 * g + 3] + d0[4 * g + 3]);
                        S1[4 * g + 0] = e1.x * (S1[4 * g + 0] + d1[4 * g + 0]); S1[4 * g + 1] = e1.y * (S1[4 * g + 1] + d1[4 * g + 1]);
                        S1[4 * g + 2] = e1.z * (S1[4 * g + 2] + d1[4 * g + 2]); S1[4 * g + 3] = e1.w * (S1[4 * g + 3] + d1[4 * g + 3]);
                    }
                    if (!(layer == 1 && c < 8)) {
                        char* orow = Ob + (size_t)gla_row0(b, dir, c) * (512 * 2);
#pragma unroll
                        for (int r = 0; r < 16; ++r) *(bf16*)(orow + (ol + sgn * ((r & 3) + 8 * (r >> 2)) * (512 * 2))) = (bf16)(cvtpk(o[cc][r], o[cc][r]) & 0xffffu);
                    }
                }
            }
            GL_BAR();
        }
    }
    asm volatile("s_waitcnt vmcnt(0)" ::: "memory");
    __syncthreads();
}
__device__ __forceinline__ void p_mix(const Ctx& a, LAS unsigned char* lds, int layer, int tid) {
    const int G = gridDim.x;
    if (G >= 256) {
#ifndef MIXREP_GLA
#define MIXREP_GLA 1
#endif
#ifndef MIXREP_CONF
#define MIXREP_CONF 1
#endif
#ifndef MIXREP_SC
#define MIXREP_SC 1
#endif
        if ((int)blockIdx.x < 128) { for (int rp = 0; rp < MIXREP_GLA; ++rp) gla_fast_task(a, lds, layer, blockIdx.x, tid); return; }
        const int cb = blockIdx.x - 128, ncb = G - 128;
        const int ntile = (layer == 0) ? 576 : 512;
        for (int rp = 0; rp < MIXREP_CONF; ++rp) for (int t = cb; t < ntile; t += ncb) conf_tile(a, lds, layer, t, tid);
        for (int rp = 0; rp < MIXREP_SC; ++rp) p_shortconv(a, layer, tid, cb, ncb);
        return;
    }
    for (int t = blockIdx.x; t < 128; t += G) gla_fast_task(a, lds, layer, t, tid);
    const int ntile = (layer == 0) ? 576 : 512;
    for (int t = blockIdx.x; t < ntile; t += gridDim.x) conf_tile(a, lds, layer, t, tid);
    p_shortconv(a, layer, tid, blockIdx.x, gridDim.x);
}
__device__ __forceinline__ void p_glaout(const Ctx& a, int layer, int tid) {
    const int lane = tid & 63, wave = tid >> 6, gw = blockIdx.x * NWAVES + wave, NGW = gridDim.x * NWAVES;
    const bf16* PROJ = (const bf16*)(a.ws() + WS_PROJ); bf16* YM = (bf16*)(a.ws() + WS_YMIX);
    const bf16* OG0 = (const bf16*)(a.ws() + WS_OGLA); const bf16* OG1 = OG0 + (size_t)MT * 512;
    const int nrows = (layer == 0) ? MT : NLAT;
    const float* gn = a.in(17) + layer * 512 + 8 * lane;
    const f32x4 g0 = *(const f32x4*)gn, g1 = *(const f32x4*)(gn + 4);
    const float gv[8] = {g0.x, g0.y, g0.z, g0.w, g1.x, g1.y, g1.z, g1.w};
    for (int row = gw; row < nrows; row += NGW) {
        const v4u f4 = *(const v4u*)(OG0 + (size_t)row * 512 + 8 * lane), b4 = *(const v4u*)(OG1 + (size_t)row * 512 + 8 * lane);
        const v4u r4 = *(const v4u*)(PROJ + (size_t)row * NP + PR + 8 * lane);
        const unsigned fw[4] = {f4.x, f4.y, f4.z, f4.w}, bw[4] = {b4.x, b4.y, b4.z, b4.w}, rw[4] = {r4.x, r4.y, r4.z, r4.w};
        float o[8], r[8]; float ss = 0.f;
#pragma unroll
        for (int q = 0; q < 4; ++q) {
            o[2 * q] = bf2f(fw[q] & 0xffffu) + bf2f(bw[q] & 0xffffu); o[2 * q + 1] = bf2f(fw[q] >> 16) + bf2f(bw[q] >> 16);
            r[2 * q] = bf2f(rw[q] & 0xffffu); r[2 * q + 1] = bf2f(rw[q] >> 16);
            ss += o[2 * q] * o[2 * q] + o[2 * q + 1] * o[2 * q + 1];
        }
        ss += __shfl_xor(ss, 1); ss += __shfl_xor(ss, 2); ss += __shfl_xor(ss, 4); ss += __shfl_xor(ss, 8);
        const float rstd = rsqrtf(ss * (1.f / 128.f) + EPS);
        float y[8];
#pragma unroll
        for (int q = 0; q < 8; ++q) y[q] = o[q] * rstd * gv[q] * silu(r[q]);
        v4u w; w.x = pk2(y[0], y[1]); w.y = pk2(y[2], y[3]); w.z = pk2(y[4], y[5]); w.w = pk2(y[6], y[7]);
        *(v4u*)(YM + (size_t)row * D_ + 256 + 8 * lane) = w;
    }
}

namespace pg8 {
#define PG8_LAS __attribute__((address_space(3)))
typedef unsigned short bf16_t;
typedef short bf16x8 __attribute__((ext_vector_type(8)));
typedef float f32x4 __attribute__((ext_vector_type(4)));
typedef unsigned u32x4 __attribute__((ext_vector_type(4)));
constexpr int BM = 256, BK = 64, HALF = 128, HTB = HALF * BK * 2  , STAGE_BYTES = 8 * HTB, NXCD = 8, WGM = 8;

__host__ __device__ __forceinline__ int lds_byte(int r, int c) { const int st = (r >> 4) * 2 + (c >> 5), rr = r & 15, cc = c & 31, ob = rr * 64 + cc * 2; return st * 1024 + (ob ^ (((ob >> 9) & 1) << 5)); }
__host__ __device__ __forceinline__ void stage_rc(int b, int& R, int& C) { const int st = b / 1024, sb = b % 1024, swz = sb ^ (((sb >> 9) & 1) << 5); R = (st >> 1) * 16 + swz / 64; C = (st & 1) * 32 + (swz % 64) / 2; }
__host__ __device__ __forceinline__ int perm32(int rho) { const int n = rho >> 4, i = rho & 15; return 8 * (i >> 2) + 4 * n + (i & 3); }

struct Unit { int pm, pn; };
struct Gemm { const bf16_t* A; const bf16_t* Bt; int M, N, K; };

struct StaticOrder {
    int nM, nN, nwg, G, c;
    __host__ __device__ void init(int M, int N, int G_, int c_) { nM = M / BM; nN = N / BM; nwg = nM * nN; G = G_; c = c_; }
    __host__ __device__ bool next(int i, Unit& u) const {
        const long L = (long)i * G + c; if (L >= nwg) return false;
        int wgid = (int)L; { const int q = nwg / NXCD, r = nwg % NXCD, xcd = wgid % NXCD, off = wgid / NXCD; wgid = (xcd < r ? xcd * (q + 1) : r * (q + 1) + (xcd - r) * q) + off; }
        const int nig = WGM * nN, gid = wgid / nig, fm = gid * WGM, gsz = (nM - fm) < WGM ? (nM - fm) : WGM;
        u.pm = fm + ((wgid % nig) % gsz); u.pn = (wgid % nig) / gsz; return true;
    }
    __device__ __forceinline__ void a_ready(const Unit&) const {}
    __device__ __forceinline__ void done(const Unit&) const {}
};


typedef float f32x2c_t __attribute__((ext_vector_type(2))); typedef __bf16 bf16x2c_t __attribute__((ext_vector_type(2)));
__device__ __forceinline__ unsigned cvt_pk_bf16(float lo, float hi) { f32x2c_t v = {lo, hi}; bf16x2c_t b = __builtin_convertvector(v, bf16x2c_t); return __builtin_bit_cast(unsigned, b); }
template <class Epi, class Sched, bool ALIGN_EPI = false, bool SP2 = false, bool FP8 = false>
__device__ __forceinline__ void gemm_phase(PG8_LAS unsigned char* lds, const Gemm g, const Sched& S, const Epi& E) {
    const int tid = otid(), wid = __builtin_amdgcn_readfirstlane(tid >> 6), lane = tid & 63, wr = wid >> 2, wc = wid & 3, fr = lane & 15, fq = lane >> 4;
    const int K = g.K, nt = K / BK;
    unsigned voffA[2], voffB[2];
#pragma unroll
    for (int i = 0; i < 2; ++i) { int R, C; stage_rc(tid * 16 + i * 8192, R, C); const int Rb = Epi::PERM ? ((R & ~31) + perm32(R & 31)) : R;
        voffA[i] = (unsigned)(R * K + C) * 2u; voffB[i] = (unsigned)(Rb * K + C) * 2u; }
    static_assert(!Sched::GATHER || SP2, "the gathered-A variant is written for the SP2 loop");
    unsigned gA0[2] = {0u, 0u}, gA1[2] = {0u, 0u}, ngA0[2] = {0u, 0u}, ngA1[2] = {0u, 0u};
#define PG8_GOFF(uix, o0, o1) do { _Pragma("unroll") for (int _i = 0; _i < 2; ++_i) { int R_, C_; stage_rc(tid * 16 + _i * 8192, R_, C_); \
        (o0)[_i] = (unsigned)S.arow((uix), R_) * (unsigned)(K * 2) + (unsigned)(C_ * 2); (o1)[_i] = (unsigned)S.arow((uix), HALF + R_) * (unsigned)(K * 2) + (unsigned)(C_ * 2); } } while (0)
#define PG8_STAGE_A0(bufoff, ptr, arr) do { if constexpr (Sched::GATHER) PG8_STAGE(bufoff, ptr, arr); else PG8_STAGE(bufoff, ptr, voffA); } while (0)
#define PG8_STAGE_A1(bufoff, ptr, arr) do { if constexpr (Sched::GATHER) PG8_STAGE(bufoff, ptr, arr); else PG8_STAGE(bufoff, (ptr) + hstep, voffA); } while (0)
    const size_t kstep = (size_t)(BK * 2);
    const size_t hstep = (size_t)HALF * K * 2;
    const size_t tstep = 2 * hstep;
    const unsigned ldsw = (unsigned)wid * 1024u;
    const int aoff = lds_byte(wr * 64 + fr, fq * 8), boff = lds_byte(wc * 32 + fr, fq * 8);
#define PG8_SA(b, h) (((b) * 2 + (h)) * HTB)
#define PG8_SB(b, h) ((4 + (b) * 2 + (h)) * HTB)
#define PG8_STAGE(bufoff, gbase, voff) do { _Pragma("unroll") for (int _i = 0; _i < 2; ++_i) \
        __builtin_amdgcn_global_load_lds((const unsigned*)((const char*)(gbase) + (voff)[_i]), (PG8_LAS unsigned*)(lds + (bufoff) + ldsw + _i * 8192), 16, 0, 0); } while (0)
#define PG8_LDA(dst, b, h) do { _Pragma("unroll") for (int m = 0; m < 4; ++m) { if constexpr (FP8) dst##8[m] = PG8_CAT8(*(const PG8_LAS bf16x8*)(lds + PG8_SA(b, h) + aoff + m * 2048), *(const PG8_LAS bf16x8*)(lds + PG8_SA(b, h) + aoff + m * 2048 + 1024)); \
        else { _Pragma("unroll") for (int k = 0; k < 2; ++k) dst[m][k] = *(const PG8_LAS bf16x8*)(lds + PG8_SA(b, h) + aoff + m * 2048 + k * 1024); } } } while (0)
#define PG8_LDB(dst, b, h) do { _Pragma("unroll") for (int n = 0; n < 2; ++n) { if constexpr (FP8) dst##8[n] = PG8_CAT8(*(const PG8_LAS bf16x8*)(lds + PG8_SB(b, h) + boff + n * 2048), *(const PG8_LAS bf16x8*)(lds + PG8_SB(b, h) + boff + n * 2048 + 1024)); \
        else { _Pragma("unroll") for (int k = 0; k < 2; ++k) dst[n][k] = *(const PG8_LAS bf16x8*)(lds + PG8_SB(b, h) + boff + n * 2048 + k * 1024); } } } while (0)
typedef int v8i_t __attribute__((ext_vector_type(8)));
typedef int v4i_t __attribute__((ext_vector_type(4)));
#define PG8_CAT8(x0, x1) __builtin_shufflevector(__builtin_bit_cast(v4i_t, (x0)), __builtin_bit_cast(v4i_t, (x1)), 0, 1, 2, 3, 4, 5, 6, 7)
#define PG8_MMA(ai, bj, At, Bt) do { __builtin_amdgcn_s_setprio(1); _Pragma("unroll") for (int m = 0; m < 4; ++m) _Pragma("unroll") for (int n = 0; n < 2; ++n) { \
        if constexpr (FP8) asm volatile("v_mfma_f32_16x16x128_f8f6f4 %0, %1, %2, %0" : "+v"(acc[ai][bj][m][n]) : "v"(Bt##8[n]), "v"(At##8[m])); \
        else { _Pragma("unroll") for (int k = 0; k < 2; ++k) acc[ai][bj][m][n] = __builtin_amdgcn_mfma_f32_16x16x32_bf16(Bt[n][k], At[m][k], acc[ai][bj][m][n], 0, 0, 0); } } \
        __builtin_amdgcn_s_setprio(0); } while (0)
#define PG8_WAIT_V(n) asm volatile("s_waitcnt vmcnt(" #n ")" ::: "memory")
#define PG8_WAIT_L(n) asm volatile("s_waitcnt lgkmcnt(" #n ")" ::: "memory")
#define PG8_BAR __builtin_amdgcn_s_barrier()
#define PG8_SCHED __builtin_amdgcn_sched_barrier(0)
    Unit cur, nxt; int ui = 0;
    if (!S.next(0, cur)) return;
    f32x4 acc[2][2][4][2];
#pragma unroll
    for (int a = 0; a < 2; ++a)
#pragma unroll
        for (int b = 0; b < 2; ++b)
#pragma unroll
            for (int m = 0; m < 4; ++m)
#pragma unroll
                for (int n = 0; n < 2; ++n) acc[a][b][m][n] = (f32x4){0.f, 0.f, 0.f, 0.f};
    bf16x8 At[4][2], B0[2][2], B1[2][2];
    v8i_t At8[4], B08[2], B18[2];
    const char* cA = Sched::GATHER ? (const char*)g.A : (const char*)g.A + (size_t)cur.pm * tstep; const char* cB = (const char*)g.Bt + (size_t)cur.pn * tstep;
    if constexpr (Sched::GATHER) PG8_GOFF(0, gA0, gA1);
    S.a_ready(cur);
    if constexpr (SP2) {
        PG8_STAGE(PG8_SB(0, 0), cB, voffB); PG8_STAGE(PG8_SB(0, 1), cB + hstep, voffB); PG8_STAGE_A0(PG8_SA(0, 0), cA, gA0); PG8_STAGE_A1(PG8_SA(0, 1), cA, gA1);
        if (wr == 1) PG8_BAR;
        PG8_WAIT_V(2); PG8_BAR;
        PG8_STAGE(PG8_SB(1, 0), cB + kstep, voffB); PG8_STAGE_A0(PG8_SA(1, 0), cA + kstep, gA0); PG8_STAGE(PG8_SB(1, 1), cB + hstep + kstep, voffB);
        PG8_WAIT_V(6); PG8_BAR;
    } else {
        PG8_STAGE(PG8_SB(0, 0), cB, voffB); PG8_STAGE(PG8_SA(0, 0), cA, voffA); PG8_STAGE(PG8_SB(0, 1), cB + hstep, voffB); PG8_STAGE(PG8_SA(0, 1), cA + hstep, voffA);
        if (wr == 1) PG8_BAR;
        PG8_WAIT_V(4); PG8_BAR;
        PG8_STAGE(PG8_SB(1, 0), cB + kstep, voffB); PG8_STAGE(PG8_SA(1, 0), cA + kstep, voffA); PG8_STAGE(PG8_SB(1, 1), cB + hstep + kstep, voffB);
        PG8_WAIT_V(6); PG8_BAR;
    }
    for (;;) {
        const bool has_next = S.next(ui + 1, nxt);
        const char* nA = (has_next && !Sched::GATHER) ? (const char*)g.A + (size_t)nxt.pm * tstep : cA; const char* nB = has_next ? (const char*)g.Bt + (size_t)nxt.pn * tstep : cB;
        if constexpr (Sched::GATHER) { if (has_next) PG8_GOFF(ui + 1, ngA0, ngA1); else { ngA0[0] = gA0[0]; ngA0[1] = gA0[1]; ngA1[0] = gA1[0]; ngA1[1] = gA1[1]; } }
#pragma unroll 1
        for (int t = 0; t < nt; t += 2) {
            const bool last = (t == nt - 2);
            const char* a1 = cA + (size_t)(t + 1) * kstep;
            const char* a2 = last ? nA : cA + (size_t)(t + 2) * kstep; const char* b2 = last ? nB : cB + (size_t)(t + 2) * kstep;
            const char* a3 = a2 + kstep; const char* b3 = b2 + kstep;
            if (last && has_next) S.a_ready(nxt);
            unsigned xA0[2], xA1[2];
            xA0[0] = last ? ngA0[0] : gA0[0]; xA0[1] = last ? ngA0[1] : gA0[1]; xA1[0] = last ? ngA1[0] : gA1[0]; xA1[1] = last ? ngA1[1] : gA1[1];
            if constexpr (SP2) {
            PG8_LDB(B0, 0, 0); PG8_LDB(B1, 0, 1); PG8_SCHED; PG8_LDA(At, 0, 0); PG8_STAGE_A1(PG8_SA(1, 1), a1, gA1);
            PG8_WAIT_V(8); PG8_WAIT_L(0); PG8_BAR; PG8_MMA(0, 0, At, B0); PG8_MMA(0, 1, At, B1); PG8_BAR; PG8_SCHED;
            PG8_LDA(At, 0, 1); PG8_STAGE(PG8_SB(0, 0), b2, voffB); PG8_STAGE(PG8_SB(0, 1), b2 + hstep, voffB); PG8_STAGE_A0(PG8_SA(0, 0), a2, xA0);
            PG8_WAIT_V(8); PG8_WAIT_L(0); PG8_BAR; PG8_MMA(1, 0, At, B0); PG8_MMA(1, 1, At, B1); PG8_BAR; PG8_SCHED;
            PG8_LDB(B0, 1, 0); PG8_LDB(B1, 1, 1); PG8_SCHED; PG8_LDA(At, 1, 0); PG8_STAGE_A1(PG8_SA(0, 1), a2, xA1);
            PG8_WAIT_V(8); PG8_WAIT_L(0); PG8_BAR; PG8_MMA(0, 0, At, B0); PG8_MMA(0, 1, At, B1); PG8_BAR; PG8_SCHED;
            PG8_LDA(At, 1, 1); PG8_STAGE(PG8_SB(1, 0), b3, voffB); PG8_STAGE(PG8_SB(1, 1), b3 + hstep, voffB); PG8_STAGE_A0(PG8_SA(1, 0), a3, xA0);
            PG8_WAIT_V(8); PG8_WAIT_L(0); PG8_BAR; PG8_MMA(1, 0, At, B0); PG8_MMA(1, 1, At, B1); PG8_BAR; PG8_SCHED;
            } else {
            PG8_LDB(B0, 0, 0); PG8_SCHED; PG8_LDA(At, 0, 0); PG8_STAGE(PG8_SA(1, 1), a1 + hstep, voffA);
            PG8_WAIT_L(8); PG8_BAR; PG8_WAIT_L(0); PG8_MMA(0, 0, At, B0); PG8_BAR; PG8_SCHED;
            PG8_LDB(B1, 0, 1); PG8_STAGE(PG8_SB(0, 0), b2, voffB);
            PG8_BAR; PG8_WAIT_L(0); PG8_MMA(0, 1, At, B1); PG8_BAR;
            PG8_LDA(At, 0, 1); PG8_STAGE(PG8_SA(0, 0), a2, voffA);
            PG8_BAR; PG8_WAIT_L(0); PG8_MMA(1, 0, At, B0); PG8_BAR; PG8_SCHED;
            PG8_STAGE(PG8_SB(0, 1), b2 + hstep, voffB);
            PG8_WAIT_V(6); PG8_BAR; PG8_MMA(1, 1, At, B1); PG8_BAR;
            PG8_LDB(B0, 1, 0); PG8_SCHED; PG8_LDA(At, 1, 0); PG8_STAGE(PG8_SA(0, 1), a2 + hstep, voffA);
            PG8_WAIT_L(8); PG8_BAR; PG8_WAIT_L(0); PG8_MMA(0, 0, At, B0); PG8_BAR; PG8_SCHED;
            PG8_LDB(B1, 1, 1); PG8_STAGE(PG8_SB(1, 0), b3, voffB);
            PG8_BAR; PG8_WAIT_L(0); PG8_MMA(0, 1, At, B1); PG8_BAR;
            PG8_LDA(At, 1, 1); PG8_STAGE(PG8_SA(1, 0), a3, voffA);
            PG8_BAR; PG8_WAIT_L(0); PG8_MMA(1, 0, At, B0); PG8_BAR; PG8_SCHED;
            PG8_STAGE(PG8_SB(1, 1), b3 + hstep, voffB);
            PG8_WAIT_V(6); PG8_BAR; PG8_MMA(1, 1, At, B1); PG8_BAR;
            }
        }
        if constexpr (FP8) asm volatile("s_nop 15\n\ts_nop 15" ::: "memory");
        if constexpr (ALIGN_EPI) { if (wr == 0) PG8_BAR; }
        if constexpr (!Epi::AFTER_DRAIN) { E(acc, cur, wr, wc, fr, fq); S.done(cur); }
        if (!has_next) break;
#pragma unroll
        for (int a = 0; a < 2; ++a)
#pragma unroll
            for (int b = 0; b < 2; ++b)
#pragma unroll
                for (int m = 0; m < 4; ++m)
#pragma unroll
                    for (int n = 0; n < 2; ++n) acc[a][b][m][n] = (f32x4){0.f, 0.f, 0.f, 0.f};
        cur = nxt; cA = nA; cB = nB; ++ui;
        if constexpr (Sched::GATHER) { gA0[0] = ngA0[0]; gA0[1] = ngA0[1]; gA1[0] = ngA1[0]; gA1[1] = ngA1[1]; }
        if constexpr (ALIGN_EPI) { if (wr == 1) PG8_BAR; }
    }
    PG8_WAIT_V(0);
    if constexpr (!ALIGN_EPI) { if (wr == 0) PG8_BAR; }
    PG8_BAR;
    if constexpr (Epi::AFTER_DRAIN) { E.fused(acc, cur, wr, wc, fr, fq, lds, wid, lane); S.done(cur); }
#undef PG8_SA
#undef PG8_SB
#undef PG8_STAGE
#undef PG8_STAGE_A0
#undef PG8_STAGE_A1
#undef PG8_GOFF
#undef PG8_LDA
#undef PG8_LDB
#undef PG8_MMA
#undef PG8_CAT8
#undef PG8_WAIT_V
#undef PG8_WAIT_L
#undef PG8_BAR
#undef PG8_SCHED
}
}

namespace pg8 {
__device__ __forceinline__ void map_tile(int wgid, int nM, int nN, int& pm, int& pn) {
    const int nwg = nM * nN;
    { const int q = nwg / NXCD, r = nwg % NXCD, xcd = wgid % NXCD, off = wgid / NXCD; wgid = (xcd < r ? xcd * (q + 1) : r * (q + 1) + (xcd - r) * q) + off; }
    const int nig = WGM * nN, gid = wgid / nig, fm = gid * WGM, gsz = (nM - fm) < WGM ? (nM - fm) : WGM;
    pm = fm + ((wgid % nig) % gsz); pn = (wgid % nig) / gsz;
}
struct DenseOrder2 {
    static constexpr bool GATHER = false;
    __device__ __forceinline__ int arow(int, int) const { return 0; }
    int nM1, nN1, nM2, nN2, pm0_2, G, c;
    __device__ __forceinline__ bool next(int i, Unit& u) const {
        const int L = i * G + c; const int n1 = nM1 * nN1, n2 = nM2 * nN2;
        if (L >= n1 + n2) return false;
        if (L < n1) map_tile(L, nM1, nN1, u.pm, u.pn); else { map_tile(L - n1, nM2, nN2, u.pm, u.pn); u.pm += pm0_2; }
        return true;
    }
    __device__ __forceinline__ void a_ready(const Unit&) const {}
    __device__ __forceinline__ void done(const Unit&) const {}
};
struct GroupedOrder {
    static constexpr bool GATHER = false;
    __device__ __forceinline__ int arow(int, int) const { return 0; }
    int te, NT, G, c;
    __device__ __forceinline__ bool next(int i, Unit& u) const {
        const int L = i * G + c; const int nM = 16 * te;
        if (L >= nM * NT) return false;
        int pmv, pnv; map_tile(L, nM, NT, pmv, pnv);
        const int e = pmv / te; u.pm = e * 18 + (pmv - e * te); u.pn = e * NT + pnv; return true;
    }
    __device__ __forceinline__ void a_ready(const Unit&) const {}
    __device__ __forceinline__ void done(const Unit&) const {}
};
struct GatherOrder : GroupedOrder {
    static constexpr bool GATHER = true;
    const PG8_LAS int* ridx;
    __device__ __forceinline__ int arow(int ui, int r) const { return ridx[ui * 256 + r]; }
};
struct EpiProj {
    static constexpr bool PERM = true, AFTER_DRAIN = false;
    bf16_t* O;
    __device__ __forceinline__ void operator()(const f32x4 (&acc)[2][2][4][2], const Unit& u, int wr, int wc, int fr, int fq) const {
        const int row0 = u.pm * BM + wr * 64 + fr, col0 = u.pn * BM + wc * 32 + 8 * fq;
#pragma unroll
        for (int ai = 0; ai < 2; ++ai)
#pragma unroll
            for (int m = 0; m < 4; ++m) { bf16_t* rowp = O + (size_t)(row0 + ai * HALF + m * 16) * NP + col0;
#pragma unroll
                for (int bj = 0; bj < 2; ++bj) { const f32x4 v0 = acc[ai][bj][m][0], v1 = acc[ai][bj][m][1];
                    u32x4 w; w.x = cvt_pk_bf16(v0[0], v0[1]); w.y = cvt_pk_bf16(v0[2], v0[3]); w.z = cvt_pk_bf16(v1[0], v1[1]); w.w = cvt_pk_bf16(v1[2], v1[3]);
                    *(u32x4*)(rowp + bj * HALF) = w; } }
    }
};
struct EpiY {
    static constexpr bool PERM = true, AFTER_DRAIN = false;
    bf16_t* O;
    __device__ __forceinline__ void operator()(const f32x4 (&acc)[2][2][4][2], const Unit& u, int wr, int wc, int fr, int fq) const {
        const int row0 = u.pm * BM + wr * 64 + fr, col0 = u.pn * BM + wc * 32 + 8 * fq;
#pragma unroll
        for (int ai = 0; ai < 2; ++ai)
#pragma unroll
            for (int m = 0; m < 4; ++m) { bf16_t* rowp = O + (size_t)(row0 + ai * HALF + m * 16) * D_ + col0;
#pragma unroll
                for (int bj = 0; bj < 2; ++bj) { const f32x4 v0 = acc[ai][bj][m][0], v1 = acc[ai][bj][m][1];
                    u32x4 w; w.x = cvt_pk_bf16(v0[0], v0[1]); w.y = cvt_pk_bf16(v0[2], v0[3]); w.z = cvt_pk_bf16(v1[0], v1[1]); w.w = cvt_pk_bf16(v1[2], v1[3]);
                    *(u32x4*)(rowp + bj * HALF) = w; } }
    }
};
__device__ __forceinline__ float silu_f(float x) { return x * __builtin_amdgcn_rcpf(1.f + __builtin_amdgcn_exp2f(-1.4426950408889634f * x)); }
struct EpiUp8 {
    static constexpr bool PERM = true, AFTER_DRAIN = false;
    unsigned char* H;
    __device__ __forceinline__ void operator()(const f32x4 (&acc)[2][2][4][2], const Unit& u, int wr, int wc, int fr, int fq) const {
        const int row0 = u.pm * BM + wr * 64 + fr, col0 = (u.pn & 7) * HALF + wc * 32 + 8 * fq;
#pragma unroll
        for (int ai = 0; ai < 2; ++ai)
#pragma unroll
            for (int m = 0; m < 4; ++m) {
                const f32x4 g0 = acc[ai][0][m][0] * W8_INV, g1 = acc[ai][0][m][1] * W8_INV, u0 = acc[ai][1][m][0] * W8_INV, u1 = acc[ai][1][m][1] * W8_INV;
                unsigned w0 = pk4_fp8(silu_f(g0[0]) * u0[0], silu_f(g0[1]) * u0[1], silu_f(g0[2]) * u0[2], silu_f(g0[3]) * u0[3]);
                unsigned w1 = pk4_fp8(silu_f(g1[0]) * u1[0], silu_f(g1[1]) * u1[1], silu_f(g1[2]) * u1[2], silu_f(g1[3]) * u1[3]);
                typedef unsigned u32x2_t __attribute__((ext_vector_type(2)));
                *(u32x2_t*)(H + (size_t)(row0 + ai * HALF + m * 16) * D_ + col0) = (u32x2_t){w0, w1}; }
    }
};
struct EpiDown {
    static constexpr bool PERM = true, AFTER_DRAIN = false;
    unsigned char* Y; const float* gate; float wscale;
    __device__ __forceinline__ void operator()(const f32x4 (&acc)[2][2][4][2], const Unit& u, int wr, int wc, int fr, int fq) const {
        const int row0 = u.pm * BM + wr * 64 + fr, col0 = (u.pn & 3) * BM + wc * 32 + 8 * fq;
        typedef unsigned u32x2_t __attribute__((ext_vector_type(2)));
#pragma unroll
        for (int ai = 0; ai < 2; ++ai)
#pragma unroll
            for (int m = 0; m < 4; ++m) { const int row = row0 + ai * HALF + m * 16; const float g = gate[row] * wscale; unsigned char* rowp = Y + (size_t)row * D_ + col0;
#pragma unroll
                for (int bj = 0; bj < 2; ++bj) { const f32x4 v0 = acc[ai][bj][m][0] * g, v1 = acc[ai][bj][m][1] * g;
                    *(u32x2_t*)(rowp + bj * HALF) = (u32x2_t){pk4_fp8(v0[0], v0[1], v0[2], v0[3]), pk4_fp8(v1[0], v1[1], v1[2], v1[3])}; } }
    }
};
}

constexpr size_t WB_IN = 0, WB_OUT = 6 * MiB, WB_13 = 8 * MiB, WB_2 = 40 * MiB;
__device__ __forceinline__ unsigned cvtpk_w(float lo, float hi) { unsigned r; asm volatile("v_cvt_pk_bf16_f32 %0, %1, %2" : "=v"(r) : "v"(lo), "v"(hi)); return r; }
__device__ __forceinline__ void transpose_item(const float* W, int N, int srccol0, bf16* WT, int kb, LAS float* scr, int lane) {
    const int k0 = 64 * kb;
    float tmp[32];
    const float* src = W + (size_t)(k0 + (lane >> 5)) * N + (srccol0 < 0 ? 0 : srccol0) + (lane & 31);
#pragma unroll
    for (int i = 0; i < 32; ++i) tmp[i] = src[(size_t)(2 * i) * N];
#pragma unroll
    for (int i = 0; i < 32; ++i) scr[(2 * i + (lane >> 5)) * 33 + (lane & 31)] = (srccol0 < 0) ? 0.f : tmp[i];
    asm volatile("s_waitcnt lgkmcnt(0)" ::: "memory");
    const int c = lane & 7;
#pragma unroll
    for (int j = 0; j < 4; ++j) { const int n = (lane >> 3) + 8 * j; const LAS float* s = scr + (8 * c) * 33 + n;
        v4u o; o.x = cvtpk_w(s[0 * 33], s[1 * 33]); o.y = cvtpk_w(s[2 * 33], s[3 * 33]); o.z = cvtpk_w(s[4 * 33], s[5 * 33]); o.w = cvtpk_w(s[6 * 33], s[7 * 33]);
        *(v4u*)(WT + (size_t)n * D_ + k0 + 8 * c) = o; }
    asm volatile("s_waitcnt lgkmcnt(0)" ::: "memory");
}
__device__ __forceinline__ void transpose_item_fp8(const float* W, int N, int srccol0, unsigned char* WT8, int kb, LAS float* scr, int lane) {
    const int k0 = 64 * kb;
    float tmp[32];
    const float* src = W + (size_t)(k0 + (lane >> 5)) * N + srccol0 + (lane & 31);
#pragma unroll
    for (int i = 0; i < 32; ++i) tmp[i] = src[(size_t)(2 * i) * N];
#pragma unroll
    for (int i = 0; i < 32; ++i) scr[(2 * i + (lane >> 5)) * 33 + (lane & 31)] = tmp[i] * W8_SCALE;
    asm volatile("s_waitcnt lgkmcnt(0)" ::: "memory");
    const int n = lane >> 1, hf = lane & 1;
    const LAS float* sp = scr + (32 * hf) * 33 + n;
    v4u o0, o1;
    o0.x = pk4_fp8(sp[0 * 33], sp[1 * 33], sp[2 * 33], sp[3 * 33]);     o0.y = pk4_fp8(sp[4 * 33], sp[5 * 33], sp[6 * 33], sp[7 * 33]);
    o0.z = pk4_fp8(sp[8 * 33], sp[9 * 33], sp[10 * 33], sp[11 * 33]);   o0.w = pk4_fp8(sp[12 * 33], sp[13 * 33], sp[14 * 33], sp[15 * 33]);
    o1.x = pk4_fp8(sp[16 * 33], sp[17 * 33], sp[18 * 33], sp[19 * 33]); o1.y = pk4_fp8(sp[20 * 33], sp[21 * 33], sp[22 * 33], sp[23 * 33]);
    o1.z = pk4_fp8(sp[24 * 33], sp[25 * 33], sp[26 * 33], sp[27 * 33]); o1.w = pk4_fp8(sp[28 * 33], sp[29 * 33], sp[30 * 33], sp[31 * 33]);
    unsigned char* dst = WT8 + (size_t)n * D_ + k0 + 32 * hf;
    *(v4u*)dst = o0; *(v4u*)(dst + 16) = o1;
    asm volatile("s_waitcnt lgkmcnt(0)" ::: "memory");
}
constexpr int WP_NRB = 96 + 32 + 1024 + 512, WP_NIT = 16 * WP_NRB;
constexpr int WP_R0 = 3600, WP_R1 = 15600, WP_R2 = 19600;
__device__ __forceinline__ void p_wprep(const Ctx& a, LAS unsigned char* lds, int layer, int tid, int it_lo, int it_hi, int worker, int nworkers) {
    const int lane = tid & 63, wave = __builtin_amdgcn_readfirstlane(tid >> 6);
    LAS float* scr = (LAS float*)(lds + wave * 16384);
    const int gw = worker * NWAVES + wave, NGW = nworkers * NWAVES;
    unsigned char* wb = a.ws() + WS_WB + (size_t)layer * WB_LAYER;
    const float* w_in = a.in(8) + (size_t)layer * D_ * DIN; const float* w_out = a.in(20) + (size_t)layer * D_ * D_;
    const float* w1 = a.in(22) + (size_t)layer * NE * D_ * D_; const float* w3 = a.in(23) + (size_t)layer * NE * D_ * D_; const float* w2 = a.in(24) + (size_t)layer * NE * D_ * D_;
    constexpr int NRB = WP_NRB;
    for (int it = it_lo + gw; it < it_hi; it += NGW) {
        const int kb = it / NRB, rb = it % NRB;
        if (rb < 96) transpose_item(w_in, DIN, ref_col(32 * rb), (bf16*)(wb + WB_IN) + (size_t)(32 * rb) * D_, kb, scr, lane);
        else if (rb < 128) transpose_item(w_out, D_, 32 * (rb - 96), (bf16*)(wb + WB_OUT) + (size_t)(32 * (rb - 96)) * D_, kb, scr, lane);
        else if (rb < 1152) { const int q = rb - 128, e = q >> 6, w = q & 63, tile = w >> 3, within = w & 7;
            transpose_item_fp8((within < 4 ? w1 : w3) + (size_t)e * D_ * D_, D_, 128 * tile + 32 * (within & 3), wb + WB_13 + ((size_t)e * 2048 + 32 * w) * D_, kb, scr, lane); }
        else { const int q = rb - 1152, e = q >> 5, w = q & 31;
            transpose_item_fp8(w2 + (size_t)e * D_ * D_, D_, 32 * w, wb + WB_2 + ((size_t)e * 1024 + 32 * w) * D_, kb, scr, lane); }
    }
}
__device__ __forceinline__ void wprep_in_slack(const Ctx& a, LAS unsigned char* lds, int nunits, int lo, int hi) {
    const int G = gridDim.x, rem = nunits % 256;
    if (G != 256 || rem == 0 || (int)blockIdx.x < rem) return;
    __syncthreads();
    p_wprep(a, lds, 1, otid(), lo, hi, (int)blockIdx.x - rem, 256 - rem);
}
#ifndef PG8_SP2
#define PG8_SP2 true
#endif
#ifndef PG8_ALIGN
#define PG8_ALIGN true
#endif
__device__ __forceinline__ void p_gemm_in_fast(const Ctx& a, LAS unsigned char* lds, int layer) {
    unsigned char* ws = a.ws();
    pg8::Gemm g{(const bf16*)(ws + WS_HN), (const bf16*)(ws + WS_WB + (size_t)layer * WB_LAYER + WB_IN), MT, NP, D_};
    pg8::DenseOrder2 S{(layer == 0) ? MT / 256 : NLAT / 256, NP / 256, (layer == 0) ? 0 : NCTX / 256, 4, NLAT / 256, (int)gridDim.x, (int)blockIdx.x};
    pg8::EpiProj E{(bf16*)(ws + WS_PROJ)};
    pg8::gemm_phase<pg8::EpiProj, pg8::DenseOrder2, PG8_ALIGN, PG8_SP2>(lds, g, S, E);
    if (layer == 0) wprep_in_slack(a, lds, (MT / 256) * (NP / 256), 0, WP_R0);
}
__device__ __forceinline__ void p_gemm_out_fast(const Ctx& a, LAS unsigned char* lds, int layer) {
    unsigned char* ws = a.ws();
    pg8::Gemm g{(const bf16*)(ws + WS_YMIX), (const bf16*)(ws + WS_WB + (size_t)layer * WB_LAYER + WB_OUT), MT, D_, D_};
    pg8::DenseOrder2 S{(layer == 0) ? MT / 256 : NLAT / 256, D_ / 256, 0, 1, 0, (int)gridDim.x, (int)blockIdx.x};
    pg8::EpiY E{(bf16*)(ws + WS_YO)};
    pg8::gemm_phase<pg8::EpiY, pg8::DenseOrder2, PG8_ALIGN, PG8_SP2>(lds, g, S, E);
    if (layer == 0) wprep_in_slack(a, lds, (MT / 256) * (D_ / 256), WP_R0, WP_R1);
}
constexpr int RIDX_OFF = RING_BYTES + 1024;
__device__ __forceinline__ void p_gemm_up_fast(const Ctx& a, LAS unsigned char* lds, int layer) {
    unsigned char* ws = a.ws();
    pg8::Gemm g{(const bf16*)(ws + WS_HN), (const bf16*)(ws + WS_WB + (size_t)layer * WB_LAYER + WB_13), MT, NE * 2048, D_ / 2};
    pg8::GatherOrder S; S.te = (layer == 0) ? 18 : 16; S.NT = 8; S.G = (int)gridDim.x; S.c = (int)blockIdx.x; S.ridx = (const LAS int*)(lds + RIDX_OFF);
    {
        const int* IDX = (const int*)(ws + WS_IDX); const int tid = otid();
        pg8::Unit u;
        for (int i = 0; i < 12 && S.next(i, u); ++i) if (tid < 256) ((LAS int*)(lds + RIDX_OFF))[i * 256 + tid] = IDX[u.pm * 256 + tid];
        __syncthreads();
    }
    pg8::EpiUp8 E{ws + WS_HID};
    pg8::gemm_phase<pg8::EpiUp8, pg8::GatherOrder, PG8_ALIGN, PG8_SP2, true>(lds, g, S, E);
}
__device__ __forceinline__ void p_gemm_down_fast(const Ctx& a, LAS unsigned char* lds, int layer) {
    unsigned char* ws = a.ws();
    pg8::Gemm g{(const bf16*)(ws + WS_HID), (const bf16*)(ws + WS_WB + (size_t)layer * WB_LAYER + WB_2), NE * SLOTS, NE * 1024, D_ / 2};
    pg8::GroupedOrder S{(layer == 0) ? 18 : 16, 4, (int)gridDim.x, (int)blockIdx.x};
    pg8::EpiDown E{ws + WS_Y2, (const float*)(ws + WS_GATE), W8_INV * Y8_SCALE};
    pg8::gemm_phase<pg8::EpiDown, pg8::GroupedOrder, PG8_ALIGN, PG8_SP2, true>(lds, g, S, E);
    if (layer == 0) wprep_in_slack(a, lds, 16 * 18 * 4, WP_R1, WP_R2);
}

__global__ void __launch_bounds__(NWAVES * 64, 2) mk_fwd(Args args) {
    extern __shared__ __attribute__((aligned(16))) unsigned char lds_raw[];
    LAS unsigned char* lds = (LAS unsigned char*)lds_raw;
    const int tid = threadIdx.x;
    for (int u = tid; u < (LDS_BYTES - LDSCTL_OFF) / 4; u += NWAVES * 64) ((LAS unsigned*)(lds + LDSCTL_OFF))[u] = 0u;
    __syncthreads();
    {
        LAS unsigned long long* tabw = (LAS unsigned long long*)(lds + LDSCTL_OFF + 64);
        if (tid < 26) tabw[tid] = (unsigned long long)args.in[tid];
        if (tid == 26) tabw[26] = (unsigned long long)args.out;
        if (tid == 27) tabw[27] = (unsigned long long)args.ws;
    }
    __syncthreads();
    Ctx ctx; ctx.tab = (const LAS unsigned long long*)(lds + LDSCTL_OFF + 64);
    XcdBarrier bar; bar.bar = (unsigned*)(args.ws + WS_CTL) + CW_BAR; bar.x = 0; bar.st = nullptr;
    if (N_LAUNCHES == 1) bar = xcd_barrier_post((unsigned*)(args.ws + WS_CTL) + CW_BAR, (volatile LAS unsigned*)(lds + MISC_OFF) + 8);
    const int lo = args.ph_lo, hi = args.ph_hi;
#define IN(k) (lo <= (k) && (k) < hi)
#if defined(REPP)
#define REPS(k) for (int rep_ = 0; rep_ < (((k) == REPP) ? NREP : 1); ++rep_)
#else
#define REPS(k)
#endif
#define SEAM(k) do { if (IN(k) && IN((k) + 1)) xcd_barrier(bar); } while (0)
    if (IN(0)) REPS(0) { __syncthreads(); p_mod(ctx, lds, otid()); __syncthreads(); p_wprep(ctx, lds, 0, otid(), 0, WP_NIT, (int)blockIdx.x, (int)gridDim.x); }
    SEAM(0);
    for (int l = 0; l < 2; ++l) {
        const int pb = 1 + 9 * l;
        if (IN(pb + 0)) REPS(pb + 0) { __syncthreads(); p_norm1(ctx, l, otid()); if (l == 1) { __syncthreads(); p_wprep(ctx, lds, 1, otid(), (gridDim.x == 256) ? WP_R2 : 0, WP_NIT, (int)blockIdx.x, (int)gridDim.x); } }
        SEAM(pb + 0);
        if (IN(pb + 1)) REPS(pb + 1) {
            __syncthreads(); p_gemm_in_fast(ctx, lds, l);
        }
        SEAM(pb + 1);
        if (IN(pb + 2)) REPS(pb + 2) { p_mix(ctx, lds, l, otid()); }
        SEAM(pb + 2);
        if (IN(pb + 3)) REPS(pb + 3) { p_glaout(ctx, l, otid()); }
        SEAM(pb + 3);
        if (IN(pb + 4)) REPS(pb + 4) {
            __syncthreads(); p_gemm_out_fast(ctx, lds, l);
        }
        SEAM(pb + 4);
        if (IN(pb + 5)) REPS(pb + 5) { __syncthreads(); p_norm2(ctx, lds, l, otid()); }
        SEAM(pb + 5);
        if (IN(pb + 6)) REPS(pb + 6) { __syncthreads(); p_topk(ctx, lds, l, otid()); }
        SEAM(pb + 6);
        if (IN(pb + 7)) REPS(pb + 7) {
            __syncthreads(); p_gemm_up_fast(ctx, lds, l);
        }
        SEAM(pb + 7);
        if (IN(pb + 8)) REPS(pb + 8) {
            __syncthreads(); p_gemm_down_fast(ctx, lds, l);
        }
        SEAM(pb + 8);
    }
    if (IN(19)) { p_norm1(ctx, 2, otid()); }
#undef IN
#undef SEAM
}

extern "C" void kernel_launch(void* const* d_in, const int* in_sizes, int n_in, void* d_out, int out_size, void* d_ws, size_t ws_size, hipStream_t stream) {
    static int grid = 0;
    if (grid == 0) {
        if (n_in != 26 || in_sizes[0] != NLAT * D_ || out_size != NLAT * D_ || ws_size < WS_END) {
            fprintf(stderr, "kernel_launch: unexpected shapes: n_in %d in0 %d out %d ws %zu (need %zu); nothing launched\n", n_in, n_in > 0 ? in_sizes[0] : -1, out_size, ws_size, (size_t)WS_END);
            grid = -1; return;
        }
        int dev = 0, cus = 0, per_cu = 0;
        if (hipGetDevice(&dev) != hipSuccess || hipDeviceGetAttribute(&cus, hipDeviceAttributeMultiprocessorCount, dev) != hipSuccess) { grid = -1; return; }
        if (hipFuncSetAttribute((const void*)mk_fwd, hipFuncAttributeMaxDynamicSharedMemorySize, LDS_BYTES) != hipSuccess) { fprintf(stderr, "kernel_launch: hipFuncSetAttribute failed\n"); grid = -1; return; }
        if (hipOccupancyMaxActiveBlocksPerMultiprocessor(&per_cu, (const void*)mk_fwd, NWAVES * 64, LDS_BYTES) != hipSuccess || per_cu < 1) {
            fprintf(stderr, "kernel_launch: occupancy query reports %d blocks per CU; nothing launched\n", per_cu); (void)hipGetLastError(); grid = -1; return;
        }
        grid = cus;
    }
    if (grid < 0) return;
    if (hipMemsetAsync((char*)d_ws + WS_CTL, 0, CTL_ZERO_BYTES, stream) != hipSuccess) return;
    Args a{};
    for (int i = 0; i < 26; ++i) a.in[i] = (const float*)d_in[i];
    a.out = (float*)d_out; a.ws = (unsigned char*)d_ws;
    for (int li = 0; li < N_LAUNCHES; ++li) {
        if (N_LAUNCHES == 1) { a.ph_lo = 0; a.ph_hi = NPHASES; } else { a.ph_lo = li; a.ph_hi = li + 1; }
        a.li = li;
        hipLaunchKernelGGL(mk_fwd, dim3(grid), dim3(NWAVES * 64), LDS_BYTES, stream, a);
        const hipError_t le = hipPeekAtLastError();
        if (le != hipSuccess) { fprintf(stderr, "kernel_launch: launch %d failed: %s\n", li, hipGetErrorName(le)); break; }
    }
}
```

```cpp
#include <hip/hip_runtime.h>
#include <cstdio>
#include <cstdint>

#ifndef MK_N_LAUNCHES
#define MK_N_LAUNCHES 1
#endif

constexpr int NB_ = 16, L_ = 2048, LC_ = 256, D_ = 1024;
constexpr int NLAT = NB_ * L_, NCTX = NB_ * LC_, MT = NLAT + NCTX;
constexpr int DIN = 2848, NP = 3072, NE = 16;
constexpr int CAP_L = 256, CAP_C = 32, SLOTS = NB_ * CAP_L + NB_ * CAP_C;
constexpr float EPS = 1e-6f;
constexpr int PK = 0, PV = 256, PAF = 768, PAB = 784, PQ = 1024, PR = 1280, PCA = 1792, PCG = 2048, PSB = 2304, PSC = 2560, PSX = 2816;
constexpr int NPHASES = 20;
constexpr int N_LAUNCHES = MK_N_LAUNCHES;

constexpr size_t MiB = 1u << 20;
constexpr size_t WS_CTL = 0, CTL_ZERO_BYTES = 32768;
constexpr size_t WS_MOD = 1 * MiB;
constexpr size_t WS_AFF = 2 * MiB;
constexpr size_t WS_IDX = 5 * MiB;
constexpr size_t WS_GATE = 5 * MiB + 512 * 1024;
constexpr size_t WS_INV = 6 * MiB;
constexpr size_t WS_X16 = 9 * MiB;
constexpr size_t WS_WB = 25 * MiB, WB_LAYER = 56 * MiB;
constexpr size_t WS_HN = 137 * MiB;
constexpr size_t WS_PROJ = 209 * MiB;
constexpr size_t WS_OGLA = 425 * MiB;
constexpr size_t WS_YMIX = 497 * MiB;
constexpr size_t WS_Y2 = 209 * MiB;
constexpr size_t WS_HID = 353 * MiB;
constexpr size_t WS_YO = 425 * MiB;
constexpr size_t WS_XA16 = WS_YMIX;
constexpr size_t WS_END = 569 * MiB;
constexpr int CW_BAR = 4096;

constexpr int NWAVES = 8;
constexpr int RING_BYTES = 131072;
constexpr int LDSCTL_OFF = RING_BYTES, MISC_OFF = LDSCTL_OFF + 320;
constexpr int LDS_BYTES = 147456;

#define GAS __attribute__((address_space(1)))
#define LAS __attribute__((address_space(3)))
typedef unsigned short bf16;
typedef unsigned v4u __attribute__((ext_vector_type(4)));
typedef unsigned v2u __attribute__((ext_vector_type(2)));
typedef float f32x4 __attribute__((ext_vector_type(4)));
typedef float f32x16 __attribute__((ext_vector_type(16)));
typedef GAS unsigned gu32;

__device__ __forceinline__ float bf2f(unsigned h) { return __uint_as_float(h << 16); }
__device__ __forceinline__ unsigned f2bf(float f) { unsigned u = __float_as_uint(f); return (u + 0x7fffu + ((u >> 16) & 1u)) >> 16; }
typedef float f32x2p_t __attribute__((ext_vector_type(2))); typedef __bf16 bf16x2p_t __attribute__((ext_vector_type(2)));
__device__ __forceinline__ unsigned pk2(float lo, float hi) { f32x2p_t v = {lo, hi}; bf16x2p_t b = __builtin_convertvector(v, bf16x2p_t); return __builtin_bit_cast(unsigned, b); }
__device__ __forceinline__ f32x4 unpack4(v2u w) { return (f32x4){__uint_as_float(w.x << 16), __uint_as_float(w.x & 0xffff0000u), __uint_as_float(w.y << 16), __uint_as_float(w.y & 0xffff0000u)}; }
__device__ __forceinline__ v2u pack4(f32x4 v) { v2u r; r.x = pk2(v.x, v.y); r.y = pk2(v.z, v.w); return r; }
__device__ __forceinline__ float wave_sum(float v) {
#pragma unroll
    for (int o = 1; o < 64; o <<= 1) v += __shfl_xor(v, o);
    return v;
}
__device__ __forceinline__ int wave_sum_i(int v) {
#pragma unroll
    for (int o = 1; o < 64; o <<= 1) v += __shfl_xor(v, o);
    return v;
}
__device__ __forceinline__ float sigm(float x) { return __builtin_amdgcn_rcpf(1.f + __builtin_amdgcn_exp2f(-1.4426950408889634f * x)); }
__device__ __forceinline__ float silu(float x) { return x * __builtin_amdgcn_rcpf(1.f + __builtin_amdgcn_exp2f(-1.4426950408889634f * x)); }

#define XB_TMO      128
#define XB_XCNT(j)  (256  + 64 * (j))
#define XB_XSUB(j)  (1280 + 64 * (j))
#define XB_XGEN(j)  (2304 + 64 * (j))
#define XB_TOP      3328
#define XB_TOPGEN   3392
#define XCD_BAR_WORDS 3456
#define XB_SPIN_CAP (1u << 18)
__device__ __forceinline__ unsigned xb_ld(unsigned* p)              { return __hip_atomic_load(p, __ATOMIC_RELAXED, __HIP_MEMORY_SCOPE_AGENT); }
__device__ __forceinline__ unsigned xb_add(unsigned* p, unsigned v) { return __hip_atomic_fetch_add(p, v, __ATOMIC_RELAXED, __HIP_MEMORY_SCOPE_AGENT); }
__device__ __forceinline__ unsigned xb_xcc_id() { return (unsigned)__builtin_amdgcn_s_getreg((3 << 11) | 20) & 0xFu; }
#define XB_SPIN(cond, bar) do { unsigned _sp = 0; while (cond) { __builtin_amdgcn_s_sleep(1); \
    if ((++_sp & 255u) == 0u) { if (xb_ld(&(bar)[XB_TMO])) break; if (_sp > XB_SPIN_CAP) { atomicAdd(&(bar)[XB_TMO], 1u); break; } } } } while (0)
struct XcdBarrier { unsigned* bar; unsigned x; volatile LAS unsigned* st; };
__device__ __forceinline__ XcdBarrier xcd_barrier_post(unsigned* bar, volatile LAS unsigned* st) {
    XcdBarrier b; b.bar = bar; b.x = xb_xcc_id(); b.st = st;
    if (threadIdx.x == 0) (void)xb_add(&bar[XB_XCNT(b.x)], 1u);
    return b;
}
__device__ __forceinline__ void xcd_barrier_complete(unsigned* bar, unsigned x, unsigned& nloc, unsigned& nx) {
    const unsigned G = gridDim.x * gridDim.y * gridDim.z;
    unsigned sum, cnt, mine, sp = 0u;
    for (;;) {
        sum = 0u; cnt = 0u; mine = 0u;
#pragma unroll
        for (unsigned j = 0; j < 16; ++j) { const unsigned c = xb_ld(&bar[XB_XCNT(j)]); sum += c; cnt += (c > 0u) ? 1u : 0u; mine = (j == x) ? c : mine; }
        if (sum == G) break;
        __builtin_amdgcn_s_sleep(1);
        if ((++sp & 255u) == 0u) { if (xb_ld(&bar[XB_TMO])) break; if (sp > XB_SPIN_CAP) { atomicAdd(&bar[XB_TMO], 1u); break; } }
    }
    nloc = mine > 0u ? mine : 1u; nx = cnt > 0u ? cnt : 1u;
}
__device__ __forceinline__ void xcd_barrier_census_wave(unsigned* bar, unsigned x, volatile LAS unsigned* st) {
    const unsigned G = gridDim.x * gridDim.y * gridDim.z, lane = threadIdx.x;
    unsigned c, sum, sp = 0u;
    for (;;) {
        c = (lane < 16u) ? xb_ld(&bar[XB_XCNT(lane)]) : 0u;
        sum = c;
#pragma unroll
        for (int o = 1; o < 16; o <<= 1) sum += (unsigned)__shfl_xor((int)sum, o);
        sum = (unsigned)__builtin_amdgcn_readfirstlane((int)sum);
        if (sum == G) break;
        __builtin_amdgcn_s_sleep(1);
        if ((++sp & 255u) == 0u) { if (__builtin_amdgcn_readfirstlane((int)xb_ld(&bar[XB_TMO]))) break; if (sp > XB_SPIN_CAP) { if (lane == 0u) atomicAdd(&bar[XB_TMO], 1u); break; } }
    }
    const unsigned cnt = (unsigned)__builtin_popcountll(__ballot(c > 0u));
    const unsigned mine = (unsigned)__builtin_amdgcn_readlane((int)c, (int)x);
    if (lane == 0u) { st[0] = mine > 0u ? mine : 1u; st[1] = cnt > 0u ? cnt : 1u; }
}
__device__ __forceinline__ void xcd_barrier(const XcdBarrier& b) {
    asm volatile("s_waitcnt vmcnt(0)" ::: "memory");
    __syncthreads();
    if (threadIdx.x < 64u && b.st[0] == 0u) xcd_barrier_census_wave(b.bar, b.x, b.st);
    if (threadIdx.x == 0) {
        unsigned* bar = b.bar;
        __builtin_amdgcn_s_waitcnt(0);
        unsigned nloc = b.st[0], nx = b.st[1];
        if (nloc == 0u) { xcd_barrier_complete(bar, b.x, nloc, nx); b.st[0] = nloc; b.st[1] = nx; }
        const unsigned old = xb_add(&bar[XB_XSUB(b.x)], 1u);
        const unsigned gen = old / nloc;
        if (old + 1u == (gen + 1u) * nloc) {
            __builtin_amdgcn_fence(__ATOMIC_RELEASE, "agent");
            asm volatile("s_waitcnt vmcnt(0)" ::: "memory");
            const unsigned og = xb_add(&bar[XB_TOP], 1u);
            const unsigned tg = og / nx;
            if (og + 1u == (tg + 1u) * nx) xb_add(&bar[XB_TOPGEN], 1u);
            else XB_SPIN(xb_ld(&bar[XB_TOPGEN]) == tg, bar);
            __builtin_amdgcn_fence(__ATOMIC_ACQUIRE, "agent");
            xb_add(&bar[XB_XGEN(b.x)], 1u);
            asm volatile("s_waitcnt vmcnt(0)" ::: "memory");
        } else {
            XB_SPIN(xb_ld(&bar[XB_XGEN(b.x)]) == gen, bar);
            __builtin_amdgcn_fence(__ATOMIC_ACQUIRE, "agent");
            asm volatile("s_waitcnt vmcnt(0)" ::: "memory");
        }
    }
    __syncthreads();
}

__device__ __forceinline__ unsigned pk4_fp8(float a, float b, float c, float d) {
    a = __builtin_amdgcn_fmed3f(a, -448.f, 448.f); b = __builtin_amdgcn_fmed3f(b, -448.f, 448.f); c = __builtin_amdgcn_fmed3f(c, -448.f, 448.f); d = __builtin_amdgcn_fmed3f(d, -448.f, 448.f);
    unsigned w = 0u;
    w = (unsigned)__builtin_amdgcn_cvt_pk_fp8_f32(a, b, (int)w, false);
    w = (unsigned)__builtin_amdgcn_cvt_pk_fp8_f32(c, d, (int)w, true);
    return w;
}
constexpr float W8_SCALE = 32.f, W8_INV = 1.f / 32.f;
constexpr float Y8_SCALE = 64.f, Y8_INV = 1.f / 64.f;
typedef float f32x2u_t __attribute__((ext_vector_type(2)));
__device__ __forceinline__ f32x4 unpack4_fp8(unsigned w) { const f32x2u_t a = __builtin_amdgcn_cvt_pk_f32_fp8((int)w, false), b = __builtin_amdgcn_cvt_pk_f32_fp8((int)w, true); return (f32x4){a.x, a.y, b.x, b.y}; }
__device__ __forceinline__ int otid() { int t = threadIdx.x; asm volatile("" : "+v"(t)); return t; }
struct Args { const float* in[26]; float* out; unsigned char* ws; int ph_lo, ph_hi, li, pad; };
struct Ctx {
    const LAS unsigned long long* tab;
    __device__ __forceinline__ unsigned long long get(int k) const {
        const unsigned long long v = tab[k];
        const unsigned lo = __builtin_amdgcn_readfirstlane((unsigned)v), hi = __builtin_amdgcn_readfirstlane((unsigned)(v >> 32));
        return ((unsigned long long)hi << 32) | lo;
    }
    __device__ __forceinline__ const float* in(int k) const { return (const float*)(const GAS float*)get(k); }
    __device__ __forceinline__ float* out() const { return (float*)(GAS float*)get(26); }
    __device__ __forceinline__ unsigned char* ws() const { return (unsigned char*)(GAS unsigned char*)get(27); }
};

__device__ __forceinline__ int ref_col(int c) {
    if (c < 256) return 768 + c;
    if (c < 768) return 1024 + (c - 256);
    if (c < 800) return 1536 + (c - 768);
    if (c < 1024) return -1;
    if (c < 1280) return 512 + (c - 1024);
    if (c < 1792) return 1568 + (c - 1280);
    if (c < 2304) return c - 1792;
    return 2080 + (c - 2304);
}

__device__ __forceinline__ void p_mod(const Ctx& a, LAS unsigned char* lds, int tid) {
    const int lane = tid & 63, wave = tid >> 6;
    LAS float* s = (LAS float*)lds;
    LAS float* red = (LAS float*)(lds + 69632);
    const float* c = a.in(1); const float* cc = a.in(3);
    float* MODp = (float*)(a.ws() + WS_MOD);
    const float* adaw = a.in(4); const float* adab = a.in(5);
    if ((int)blockIdx.x < 192) {
        float cv[34];
#pragma unroll
        for (int k = 0; k < 34; ++k) { const int i = tid + 512 * k; cv[k] = (i < 16 * 1024) ? c[i] : cc[i - 16 * 1024]; }
#pragma unroll
        for (int k = 0; k < 34; ++k) { const float v = cv[k]; s[tid + 512 * k] = v / (1.f + expf(-v)); }
    }
    __syncthreads();
    for (int task = blockIdx.x; task < 192; task += gridDim.x) {
        const int l = task / 96, n0 = (task % 96) * 64;
        const float* W = adaw + (size_t)l * 1024 * 6144 + n0 + lane;
        float acc[17];
#pragma unroll
        for (int j = 0; j < 17; ++j) acc[j] = 0.f;
        const int k0 = wave * 128;
        float wn[8];
#pragma unroll
        for (int u = 0; u < 8; ++u) wn[u] = W[(size_t)(k0 + u) * 6144];
#pragma unroll 1
        for (int k = k0; k < k0 + 128; k += 8) {
            float w[8];
#pragma unroll
            for (int u = 0; u < 8; ++u) w[u] = wn[u];
            if (k + 8 < k0 + 128) {
#pragma unroll
                for (int u = 0; u < 8; ++u) wn[u] = W[(size_t)(k + 8 + u) * 6144];
            }
            __builtin_amdgcn_sched_barrier(0);
            const LAS float* sp = s + k;
#pragma unroll
            for (int u4 = 0; u4 < 2; ++u4) {
                asm volatile("" : "+v"(sp) : "v"(acc[16]));
#pragma unroll
                for (int j = 0; j < 17; ++j) { const f32x4 sv = *(const LAS f32x4*)(sp + j * 1024 + 4 * u4); acc[j] += sv.x * w[4 * u4] + sv.y * w[4 * u4 + 1] + sv.z * w[4 * u4 + 2] + sv.w * w[4 * u4 + 3]; }
            }
        }
#pragma unroll
        for (int j = 0; j < 17; ++j) red[(wave * 17 + j) * 64 + lane] = acc[j];
        __syncthreads();
        for (int i = tid; i < 17 * 64; i += 512) {
            const int j = i >> 6, n = i & 63; float t = 0.f;
#pragma unroll
            for (int w = 0; w < 8; ++w) t += red[(w * 17 + j) * 64 + n];
            MODp[(size_t)(l * 17 + j) * 6144 + n0 + n] = t + adab[l * 6144 + n0 + n];
        }
        __syncthreads();
    }
}

template <int M> struct RawX { typedef v2u t; };
template <> struct RawX<0> { typedef f32x4 t; };
template <int MODE> __device__ __forceinline__ void p_norm1(const Ctx& a, int tid) {
    typedef typename RawX<MODE>::t rawx_t;
    const int lane = tid & 63, wave = tid >> 6;
    const int gw = blockIdx.x * NWAVES + wave, NGW = gridDim.x * NWAVES;
    constexpr int npairs = ((MODE == 2) ? NLAT : MT) / 2;
    constexpr int lp = (MODE == 1) ? 0 : 1;
    const float* MODp = (const float*)(a.ws() + WS_MOD);
    const int* INV = (const int*)(a.ws() + WS_INV);
    const unsigned char* Y2 = a.ws() + WS_Y2;
    bf16* HN = (bf16*)(a.ws() + WS_HN);
    const bf16* YOp = (const bf16*)(a.ws() + WS_YO);
    const float* xin = a.in(0); const float* cin = a.in(2); bf16* X16 = (bf16*)(a.ws() + WS_X16); float* OUTp = a.out();
    const bf16* XA16 = (const bf16*)(a.ws() + WS_XA16);
    const float* fwp = a.in(25); const float* n1w = a.in(6);
    rawx_t nx[8]; v2u ny[8]; unsigned ng[2][4][4];
    int inv_c0 = -1, inv_c1 = -1, inv_n0 = -1, inv_n1 = -1;
    auto ldinv = [&](int pr, int& i0, int& i1) { const int row = 2 * pr; i0 = (lane < 16) ? INV[(size_t)row * 16 + lane] : -1; i1 = (lane < 16) ? INV[(size_t)(row + 1) * 16 + lane] : -1; };
    auto issue_rows = [&](int pr) {
        const int row = 2 * pr;
        if (MODE == 0) { const float* src = ((row >= NLAT) ? cin + (size_t)(row - NLAT) * D_ : xin + (size_t)row * D_) + 4 * lane;
#pragma unroll
            for (int q = 0; q < 4; ++q) { *(f32x4*)&nx[q] = *(const f32x4*)(src + 256 * q); *(f32x4*)&nx[4 + q] = *(const f32x4*)(src + D_ + 256 * q); } }
        else { const bf16* src = ((MODE == 1) ? XA16 : (const bf16*)X16) + (size_t)row * D_ + 4 * lane;
#pragma unroll
            for (int q = 0; q < 4; ++q) { *(v2u*)&nx[q] = *(const v2u*)(src + 256 * q); *(v2u*)&nx[4 + q] = *(const v2u*)(src + D_ + 256 * q); } }
        if (MODE == 2) { const bf16* yo = YOp + (size_t)row * D_ + 4 * lane;
#pragma unroll
            for (int q = 0; q < 4; ++q) { ny[q] = *(const v2u*)(yo + 256 * q); ny[4 + q] = *(const v2u*)(yo + D_ + 256 * q); } }
    };
    auto issue_gather = [&](int inv, unsigned (&g)[4][4]) {
        unsigned mask = (unsigned)(__ballot(inv >= 0) & 0xffffull);
#pragma unroll
        for (int k = 0; k < 4; ++k) {
            const bool have = mask != 0u;
            const int e = have ? (int)__builtin_ctz(mask) : 0;
            const int slot = have ? __builtin_amdgcn_readlane(inv, e) : 0;
            const unsigned char* yp = Y2 + ((size_t)e * SLOTS + slot) * D_ + 4 * lane;
#pragma unroll
            for (int q = 0; q < 4; ++q) g[k][q] = *(const unsigned*)(yp + 256 * q);
            mask &= mask - 1u;
        }
    };
    auto combine = [&](f32x4 (&v)[4], int inv, const unsigned (&g)[4][4], const v2u* yo, const f32x4 (&m2q)[4], const f32x4 (&m5q)[4]) {
        f32x4 sum[4];
#pragma unroll
        for (int q = 0; q < 4; ++q) sum[q] = (f32x4){0.f, 0.f, 0.f, 0.f};
        unsigned mask = (unsigned)(__ballot(inv >= 0) & 0xffffull);
        const int cnt = __builtin_popcount(mask);
#pragma unroll
        for (int k = 0; k < 4; ++k) { const float w = (k < cnt) ? Y8_INV : 0.f;
#pragma unroll
            for (int q = 0; q < 4; ++q) sum[q] += unpack4_fp8(g[k][q]) * w;
            mask &= mask - 1u; }
        while (mask != 0u) {
            const unsigned char* yp[4]; float wgt[4];
#pragma unroll
            for (int k = 0; k < 4; ++k) {
                const bool have = mask != 0u;
                const int e = have ? (int)__builtin_ctz(mask) : 0;
                const int slot = have ? __builtin_amdgcn_readlane(inv, e) : 0;
                yp[k] = Y2 + ((size_t)e * SLOTS + slot) * D_ + 4 * lane; wgt[k] = have ? Y8_INV : 0.f;
                mask &= mask - 1u;
            }
            unsigned ld[4][4];
#pragma unroll
            for (int k = 0; k < 4; ++k)
#pragma unroll
                for (int q = 0; q < 4; ++q) ld[k][q] = *(const unsigned*)(yp[k] + 256 * q);
#pragma unroll
            for (int k = 0; k < 4; ++k)
#pragma unroll
                for (int q = 0; q < 4; ++q) sum[q] += unpack4_fp8(ld[k][q]) * wgt[k];
        }
#pragma unroll
        for (int q = 0; q < 4; ++q) {
            if (MODE == 2) v[q] += m2q[q] * unpack4(yo[q]);
            v[q] += m5q[q] * sum[q];
        }
    };
    if (MODE != 0) { if (gw < npairs) ldinv(gw, inv_c0, inv_c1); if (gw + NGW < npairs) ldinv(gw + NGW, inv_n0, inv_n1); }
    if (gw < npairs) { issue_rows(gw); if (MODE != 0) { issue_gather(inv_c0, ng[0]); issue_gather(inv_c1, ng[1]); } }
    for (int pr = gw; pr < npairs; pr += NGW) {
        const int row = 2 * pr;
        const bool isctx = row >= NLAT;
        const int j = isctx ? 16 : (row >> 11);
        f32x4 m2q[4], m5q[4], aq[4], bq[4], cq[4];
        if (MODE != 0) { const float* m5 = MODp + (size_t)(lp * 17 + j) * 6144 + 5120 + 4 * lane; const float* m2 = MODp + (size_t)(lp * 17 + j) * 6144 + 2048 + 4 * lane;
#pragma unroll
            for (int q = 0; q < 4; ++q) { m5q[q] = *(const f32x4*)(m5 + 256 * q); if (MODE == 2) m2q[q] = *(const f32x4*)(m2 + 256 * q); } }
        if (MODE == 2) {
#pragma unroll
            for (int q = 0; q < 4; ++q) aq[q] = *(const f32x4*)(fwp + 4 * lane + 256 * q);
        } else {
            constexpr int l = (MODE == 0) ? 0 : 1;
            const float* nw = n1w + l * D_ + 4 * lane; const float* sh = MODp + (size_t)(l * 17 + j) * 6144 + 4 * lane; const float* sc = sh + 1024;
#pragma unroll
            for (int q = 0; q < 4; ++q) { aq[q] = *(const f32x4*)(nw + 256 * q); bq[q] = *(const f32x4*)(sc + 256 * q); cq[q] = *(const f32x4*)(sh + 256 * q); }
        }
        f32x4 v0[4], v1[4]; v2u cy[8]; unsigned cg[2][4][4];
        const int ci0 = inv_c0, ci1 = inv_c1;
#pragma unroll
        for (int q = 0; q < 4; ++q) {
            if (MODE == 0) { v0[q] = *(const f32x4*)&nx[q]; v1[q] = *(const f32x4*)&nx[4 + q]; } else { v0[q] = unpack4(*(const v2u*)&nx[q]); v1[q] = unpack4(*(const v2u*)&nx[4 + q]); }
        }
        if (MODE == 2) {
#pragma unroll
            for (int q = 0; q < 8; ++q) cy[q] = ny[q];
        }
        if (MODE != 0) {
#pragma unroll
            for (int r = 0; r < 2; ++r)
#pragma unroll
                for (int k = 0; k < 4; ++k)
#pragma unroll
                    for (int q = 0; q < 4; ++q) cg[r][k][q] = ng[r][k][q];
        }
        if (MODE != 0) { inv_c0 = inv_n0; inv_c1 = inv_n1; if (pr + 2 * NGW < npairs) ldinv(pr + 2 * NGW, inv_n0, inv_n1); }
        if (pr + NGW < npairs) { issue_rows(pr + NGW); if (MODE != 0) { issue_gather(inv_c0, ng[0]); issue_gather(inv_c1, ng[1]); } }
        __builtin_amdgcn_sched_barrier(0);
        if (MODE != 0) {
            combine(v0, ci0, cg[0], cy, m2q, m5q);
            combine(v1, ci1, cg[1], cy + 4, m2q, m5q);
            if (MODE == 1 && !isctx) {
                bf16* x16 = X16 + (size_t)row * D_ + 4 * lane;
#pragma unroll
                for (int q = 0; q < 4; ++q) { *(v2u*)(x16 + 256 * q) = pack4(v0[q]); *(v2u*)(x16 + D_ + 256 * q) = pack4(v1[q]); }
            }
        }
        float ss0 = 0.f, ss1 = 0.f;
#pragma unroll
        for (int q = 0; q < 4; ++q) {
            ss0 += (v0[q].x * v0[q].x + v0[q].y * v0[q].y) + (v0[q].z * v0[q].z + v0[q].w * v0[q].w);
            ss1 += (v1[q].x * v1[q].x + v1[q].y * v1[q].y) + (v1[q].z * v1[q].z + v1[q].w * v1[q].w);
        }
        ss0 = wave_sum(ss0); ss1 = wave_sum(ss1);
        const float rstd0 = rsqrtf(ss0 * (1.f / D_) + EPS), rstd1 = rsqrtf(ss1 * (1.f / D_) + EPS);
        if (MODE == 2) {
            float* dst = OUTp + (size_t)row * D_ + 4 * lane;
#pragma unroll
            for (int q = 0; q < 4; ++q) { *(f32x4*)(dst + 256 * q) = v0[q] * rstd0 * aq[q]; *(f32x4*)(dst + D_ + 256 * q) = v1[q] * rstd1 * aq[q]; }
        } else {
#pragma unroll
            for (int q = 0; q < 4; ++q) {
                const f32x4 g = aq[q] * (bq[q] + 1.f), bsh = cq[q];
                *(v2u*)(HN + (size_t)row * D_ + 4 * lane + 256 * q) = pack4(v0[q] * rstd0 * g + bsh);
                *(v2u*)(HN + (size_t)(row + 1) * D_ + 4 * lane + 256 * q) = pack4(v1[q] * rstd1 * g + bsh);
            }
        }
    }
}

__device__ __forceinline__ float reduce16(const float (&t)[16], int lane) {
    const bool b5 = lane & 32, b4 = lane & 16, b3 = lane & 8, b2 = lane & 4;
    float u[8], w[4], x[2];
#pragma unroll
    for (int e = 0; e < 8; ++e) { const float keep = b5 ? t[e + 8] : t[e], send = b5 ? t[e] : t[e + 8]; u[e] = keep + __shfl_xor(send, 32); }
#pragma unroll
    for (int e = 0; e < 4; ++e) { const float keep = b4 ? u[e + 4] : u[e], send = b4 ? u[e] : u[e + 4]; w[e] = keep + __shfl_xor(send, 16); }
#pragma unroll
    for (int e = 0; e < 2; ++e) { const float keep = b3 ? w[e + 2] : w[e], send = b3 ? w[e] : w[e + 2]; x[e] = keep + __shfl_xor(send, 8); }
    const float keep = b2 ? x[1] : x[0], send = b2 ? x[0] : x[1];
    float y = keep + __shfl_xor(send, 4);
    y += __shfl_xor(y, 2); y += __shfl_xor(y, 1);
    return y;
}
template <int LAYER> __device__ __forceinline__ void p_norm2(const Ctx& a, LAS unsigned char* lds, int tid) {
    constexpr int layer = LAYER;
    const int lane = tid & 63, wave = tid >> 6;
    const int gw = blockIdx.x * NWAVES + wave, NGW = gridDim.x * NWAVES;
    const int npairs = ((layer == 0) ? MT : NLAT) / 2;
    const float* MODp = (const float*)(a.ws() + WS_MOD);
    unsigned char* HN8 = a.ws() + WS_HN;
    const bf16* YO = (const bf16*)(a.ws() + WS_YO);
    float* AFF = (float*)(a.ws() + WS_AFF);
    LAS float* rwT = (LAS float*)lds;
    const float* rw = a.in(21) + (size_t)layer * D_ * NE;
    const bf16* X16 = (const bf16*)(a.ws() + WS_X16); bf16* XA16 = (bf16*)(a.ws() + WS_XA16); const float* n2w = a.in(7);
    const float* xin = a.in(0); const float* cin = a.in(2);
    typedef f32x4 rawx_t;
    rawx_t nx[8]; v2u ny[8];
    auto xptr = [&](int pr) -> const unsigned char* { const int row = 2 * pr;
        if (layer == 0) return (const unsigned char*)(((row >= NLAT) ? cin + (size_t)(row - NLAT) * D_ : xin + (size_t)row * D_) + 4 * lane);
        return (const unsigned char*)(X16 + (size_t)row * D_ + 4 * lane); };
    auto ldx = [&](const unsigned char* p, int q, int r) -> rawx_t {
        if (layer == 0) return *(const f32x4*)(p + (size_t)r * D_ * 4 + 1024 * q);
        const v2u t = *(const v2u*)(p + (size_t)r * D_ * 2 + 512 * q); return (rawx_t){__uint_as_float(t.x), __uint_as_float(t.y), 0.f, 0.f}; };
    auto cvx = [&](const rawx_t& t) -> f32x4 { if (layer == 0) return t; return unpack4((v2u){__float_as_uint(t.x), __float_as_uint(t.y)}); };
    auto m2ptr = [&](int pr) -> const float* { const int row = 2 * pr; const int jj = (row >= NLAT) ? 16 : (row >> 11); return MODp + (size_t)(layer * 17 + jj) * 6144 + 2048 + 4 * lane; };
    if (gw < npairs) {
        const unsigned char* p = xptr(gw); const bf16* yp = YO + (size_t)(2 * gw) * D_ + 4 * lane;
#pragma unroll
        for (int q = 0; q < 4; ++q) { nx[q] = ldx(p, q, 0); nx[4 + q] = ldx(p, q, 1); ny[q] = *(const v2u*)(yp + 256 * q); ny[4 + q] = *(const v2u*)(yp + D_ + 256 * q); }
    }
    {
        f32x4 rv[8];
#pragma unroll
        for (int k = 0; k < 8; ++k) rv[k] = *(const f32x4*)(rw + 4 * (tid + 512 * k));
#pragma unroll
        for (int k = 0; k < 8; ++k) { const int kk = (tid + 512 * k) >> 2, e0 = 4 * (tid & 3);
            rwT[(e0 + 0) * 1024 + kk] = rv[k].x; rwT[(e0 + 1) * 1024 + kk] = rv[k].y; rwT[(e0 + 2) * 1024 + kk] = rv[k].z; rwT[(e0 + 3) * 1024 + kk] = rv[k].w; }
    }
    __syncthreads();
    for (int pr = gw; pr < npairs; pr += NGW) {
        const int row = 2 * pr;
        const bool isctx = row >= NLAT;
        const int j = isctx ? 16 : (row >> 11);
        const bool more = pr + NGW < npairs;
        const unsigned char* pn = xptr(more ? pr + NGW : pr); const bf16* ypn = YO + (size_t)(2 * (more ? pr + NGW : pr)) * D_ + 4 * lane;
        const float* m2 = m2ptr(pr);
        const float* sh = MODp + (size_t)(layer * 17 + j) * 6144 + 3072 + 4 * lane;
        const float* sc = sh + 1024;
        f32x4 scq[4], shq[4], nwq[4], nm2[4];
#pragma unroll
        for (int q = 0; q < 4; ++q) nm2[q] = *(const f32x4*)(m2 + 256 * q);
#pragma unroll
        for (int q = 0; q < 4; ++q) { scq[q] = *(const f32x4*)(sc + 256 * q); shq[q] = *(const f32x4*)(sh + 256 * q); nwq[q] = *(const f32x4*)(n2w + layer * D_ + 4 * lane + 256 * q); }
        __builtin_amdgcn_sched_barrier(0);
        f32x4 v0[4], v1[4];
        float ss0 = 0.f, ss1 = 0.f;
#pragma unroll
        for (int q = 0; q < 4; ++q) {
            const f32x4 g2 = nm2[q];
            v0[q] = cvx(nx[q]) + g2 * unpack4(ny[q]);
            v1[q] = cvx(nx[4 + q]) + g2 * unpack4(ny[4 + q]);
            ss0 += (v0[q].x * v0[q].x + v0[q].y * v0[q].y) + (v0[q].z * v0[q].z + v0[q].w * v0[q].w);
            ss1 += (v1[q].x * v1[q].x + v1[q].y * v1[q].y) + (v1[q].z * v1[q].z + v1[q].w * v1[q].w);
        }
        if (layer == 0) {
            bf16* xa = XA16 + (size_t)row * D_ + 4 * lane;
#pragma unroll
            for (int q = 0; q < 4; ++q) { *(v2u*)(xa + 256 * q) = pack4(v0[q]); *(v2u*)(xa + D_ + 256 * q) = pack4(v1[q]); }
        }
        ss0 = wave_sum(ss0); ss1 = wave_sum(ss1);
        const float rstd0 = rsqrtf(ss0 * (1.f / D_) + EPS), rstd1 = rsqrtf(ss1 * (1.f / D_) + EPS);
#pragma unroll
        for (int q = 0; q < 4; ++q) {
            const f32x4 g = nwq[q] * (scq[q] + 1.f), bsh = shq[q];
            v0[q] = v0[q] * rstd0 * g + bsh; v1[q] = v1[q] * rstd1 * g + bsh;
            *(unsigned*)(HN8 + (size_t)row * D_ + 4 * lane + 256 * q) = pk4_fp8(v0[q].x, v0[q].y, v0[q].z, v0[q].w);
            *(unsigned*)(HN8 + (size_t)(row + 1) * D_ + 4 * lane + 256 * q) = pk4_fp8(v1[q].x, v1[q].y, v1[q].z, v1[q].w);
        }
        __builtin_amdgcn_sched_barrier(0);
        if (more) {
#pragma unroll
            for (int q = 0; q < 4; ++q) { nx[q] = ldx(pn, q, 0); nx[4 + q] = ldx(pn, q, 1); ny[q] = *(const v2u*)(ypn + 256 * q); ny[4 + q] = *(const v2u*)(ypn + D_ + 256 * q); }
        }
        __builtin_amdgcn_sched_barrier(0);
        float t0[16], t1[16];
#pragma unroll
        for (int e = 0; e < 16; ++e) { t0[e] = 0.f; t1[e] = 0.f; }
        const LAS float* rwq = rwT + 4 * lane;
#pragma unroll
        for (int q = 0; q < 4; ++q) {
            const f32x4 h0 = v0[q], h1 = v1[q];
#pragma unroll
            for (int eh = 0; eh < 16; eh += 8) {
                asm volatile("" : "+v"(rwq) : "v"(t0[(eh + 15) & 15]), "v"(t1[(eh + 15) & 15]));
#pragma unroll
                for (int e = eh; e < eh + 8; ++e) {
                    const f32x4 w = *(const LAS f32x4*)(rwq + 256 * q + e * 1024);
                    t0[e] += (h0.x * w.x + h0.y * w.y) + (h0.z * w.z + h0.w * w.w);
                    t1[e] += (h1.x * w.x + h1.y * w.y) + (h1.z * w.z + h1.w * w.w);
                }
            }
        }
        const float l0 = reduce16(t0, lane), l1 = reduce16(t1, lane);
        float m0 = l0, m1 = l1;
#pragma unroll
        for (int o = 4; o < 64; o <<= 1) { m0 = fmaxf(m0, __shfl_xor(m0, o)); m1 = fmaxf(m1, __shfl_xor(m1, o)); }
        const float e0 = expf(l0 - m0), e1 = expf(l1 - m1);
        float s0 = e0, s1 = e1;
#pragma unroll
        for (int o = 4; o < 64; o <<= 1) { s0 += __shfl_xor(s0, o); s1 += __shfl_xor(s1, o); }
        if ((lane & 3) == 0) { AFF[(size_t)row * 16 + (lane >> 2)] = e0 / s0; AFF[(size_t)(row + 1) * 16 + (lane >> 2)] = e1 / s1; }
    }
}

__device__ __forceinline__ int block_excl_scan(int val, LAS unsigned* tmp, int lane, int wave, int& total) {
    int inc = val;
#pragma unroll
    for (int d = 1; d < 64; d <<= 1) { const int t = __shfl_up(inc, d); if (lane >= d) inc += t; }
    if (lane == 63) tmp[wave] = (unsigned)inc;
    __syncthreads();
    int woff = 0, tot = 0;
#pragma unroll
    for (int w = 0; w < 8; ++w) { const int x = (int)tmp[w]; woff += (w < wave) ? x : 0; tot += x; }
    __syncthreads();
    total = tot;
    return woff + inc - val;
}
__device__ __forceinline__ void topk_task(const Ctx& a, LAS unsigned char* lds, int b, int e, bool isctx, int tid) {
    const int lane = tid & 63, wave = tid >> 6;
    const int Lr = isctx ? LC_ : L_, cap = isctx ? CAP_C : CAP_L;
    const int row0 = isctx ? NLAT + b * LC_ : b * L_;
    const int slot0 = isctx ? NB_ * CAP_L + b * CAP_C : b * CAP_L;
    LAS unsigned* wsum = (LAS unsigned*)lds;
    LAS unsigned* tmp = wsum + 16;
    const float* AFF = (const float*)(a.ws() + WS_AFF);
    int* IDX = (int*)(a.ws() + WS_IDX); float* GATE = (float*)(a.ws() + WS_GATE); int* INV = (int*)(a.ws() + WS_INV);
    unsigned key[4];
#pragma unroll
    for (int i = 0; i < 4; ++i) { const int t = 4 * tid + i; key[i] = (t < Lr) ? __float_as_uint(AFF[(size_t)(row0 + t) * 16 + e]) : 0u; }
    unsigned T = 0u;
    typedef unsigned v4u_t __attribute__((ext_vector_type(4)));
    LAS v4u_t* wcnt = (LAS v4u_t*)(lds + 256);
#pragma unroll 1
    for (int it = 0; it < 16; ++it) {
        const int sh = 30 - 2 * it;
        const unsigned c1 = T | (1u << sh), c2 = T | (2u << sh), c3 = T | (3u << sh);
        int n1 = 0, n2 = 0, n3 = 0;
#pragma unroll
        for (int i = 0; i < 4; ++i) {
            n1 += __builtin_popcountll(__builtin_amdgcn_ballot_w64(key[i] >= c1));
            n2 += __builtin_popcountll(__builtin_amdgcn_ballot_w64(key[i] >= c2));
            n3 += __builtin_popcountll(__builtin_amdgcn_ballot_w64(key[i] >= c3));
        }
        if (lane == 0) wcnt[(it & 1) * 8 + wave] = (v4u_t){(unsigned)n1, (unsigned)n2, (unsigned)n3, 0u};
        __syncthreads();
        unsigned t1 = 0, t2 = 0, t3 = 0;
#pragma unroll
        for (int w = 0; w < 8; ++w) { const v4u_t x = wcnt[(it & 1) * 8 + w]; t1 += x.x; t2 += x.y; t3 += x.z; }
        T = (t3 >= (unsigned)cap) ? c3 : (t2 >= (unsigned)cap) ? c2 : (t1 >= (unsigned)cap) ? c1 : T;
    }
    __syncthreads();
    const int ngt_mine = (key[0] > T) + (key[1] > T) + (key[2] > T) + (key[3] > T);
    const int neq_mine = (key[0] == T) + (key[1] == T) + (key[2] == T) + (key[3] == T);
    int ngt_tot, neq_tot;
    (void)block_excl_scan(ngt_mine, tmp, lane, wave, ngt_tot);
    int eqrank = block_excl_scan(neq_mine, tmp, lane, wave, neq_tot);
    const int need_eq = cap - ngt_tot;
    bool sel[4]; int nsel = 0;
#pragma unroll
    for (int i = 0; i < 4; ++i) {
        const bool eq = key[i] == T;
        sel[i] = (key[i] > T) || (eq && eqrank < need_eq);
        eqrank += eq ? 1 : 0; nsel += sel[i] ? 1 : 0;
    }
    int seltot;
    int slot = block_excl_scan(nsel, tmp, lane, wave, seltot);
#pragma unroll
    for (int i = 0; i < 4; ++i) {
        const int t = 4 * tid + i;
        if (t < Lr) {
            const int row = row0 + t;
            if (sel[i]) {
                IDX[e * SLOTS + slot0 + slot] = row; GATE[e * SLOTS + slot0 + slot] = __uint_as_float(key[i]);
                INV[(size_t)row * 16 + e] = slot0 + slot; ++slot;
            } else INV[(size_t)row * 16 + e] = -1;
        }
    }
    __syncthreads();
}
__device__ __forceinline__ void p_topk(const Ctx& a, LAS unsigned char* lds, int layer, int tid) {
    const int ntask = (layer == 0) ? 512 : 256;
    for (int t = blockIdx.x; t < ntask; t += gridDim.x) {
        const bool isctx = t >= 256; const int u = t & 255;
        topk_task(a, lds, u >> 4, u & 15, isctx, tid);
    }
}

__device__ __forceinline__ void unpack8(v4u w, float (&o)[8]) {
    o[0] = bf2f(w.x & 0xffffu); o[1] = bf2f(w.x >> 16); o[2] = bf2f(w.y & 0xffffu); o[3] = bf2f(w.y >> 16);
    o[4] = bf2f(w.z & 0xffffu); o[5] = bf2f(w.z >> 16); o[6] = bf2f(w.w & 0xffffu); o[7] = bf2f(w.w >> 16);
}
__device__ __forceinline__ void p_shortconv(const Ctx& a, int layer, int tid, int bidx, int nblk) {
    const bf16* PROJ = (const bf16*)(a.ws() + WS_PROJ); bf16* YM = (bf16*)(a.ws() + WS_YMIX);
    const int nrows = (layer == 0) ? MT : NLAT;
    const float* w = a.in(18) + layer * 3 * 256; const float* bb = a.in(19) + layer * 256;
    for (int i = bidx * 512 + tid; i < (nrows / 8) * 32; i += nblk * 512) {
        const int row0 = (i >> 5) * 8, cg = i & 31;
        const bool isctx = row0 >= NLAT;
        const int t0 = isctx ? ((row0 - NLAT) & (LC_ - 1)) : (row0 & (L_ - 1)); const int Lr = isctx ? LC_ : L_;
        const bf16* p = PROJ + (size_t)row0 * NP + cg * 8;
        v4u c4[10], x4[10], b4[8];
#pragma unroll
        for (int d = 0; d < 10; ++d) {
            const int tt = t0 + d - 1; const bool ok = (tt >= 0 && tt < Lr);
            c4[d] = ok ? *(const v4u*)(p + (ptrdiff_t)(d - 1) * NP + PSC) : (v4u){0u, 0u, 0u, 0u};
            x4[d] = ok ? *(const v4u*)(p + (ptrdiff_t)(d - 1) * NP + PSX) : (v4u){0u, 0u, 0u, 0u};
        }
#pragma unroll
        for (int d = 0; d < 8; ++d) b4[d] = *(const v4u*)(p + (size_t)d * NP + PSB);
        float w0[8], w1[8], w2[8], bv[8];
#pragma unroll
        for (int q = 0; q < 8; ++q) { w0[q] = w[cg * 8 + q]; w1[q] = w[256 + cg * 8 + q]; w2[q] = w[512 + cg * 8 + q]; bv[q] = bb[cg * 8 + q]; }
        float up[8], uc[8], un[8];
        { float cf[8], xf[8]; unpack8(c4[0], cf); unpack8(x4[0], xf);
#pragma unroll
          for (int q = 0; q < 8; ++q) up[q] = cf[q] * xf[q];
          unpack8(c4[1], cf); unpack8(x4[1], xf);
#pragma unroll
          for (int q = 0; q < 8; ++q) uc[q] = cf[q] * xf[q]; }
#pragma unroll
        for (int d = 0; d < 8; ++d) {
            float cf[8], xf[8], bg[8], o[8];
            unpack8(c4[d + 2], cf); unpack8(x4[d + 2], xf); unpack8(b4[d], bg);
#pragma unroll
            for (int q = 0; q < 8; ++q) { un[q] = cf[q] * xf[q]; o[q] = bg[q] * (w0[q] * up[q] + w1[q] * uc[q] + w2[q] * un[q] + bv[q]); up[q] = uc[q]; uc[q] = un[q]; }
            v4u r; r.x = pk2(o[0], o[1]); r.y = pk2(o[2], o[3]); r.z = pk2(o[4], o[5]); r.w = pk2(o[6], o[7]);
            *(v4u*)(YM + (size_t)(row0 + d) * D_ + 768 + cg * 8) = r;
        }
    }
}
__device__ __forceinline__ void conf_tile(const Ctx& a, LAS unsigned char* lds, int layer, int tile, int tid) {
    const int lane = tid & 63, wave = tid >> 6;
    const bf16* PROJ = (const bf16*)(a.ws() + WS_PROJ); bf16* YM = (bf16*)(a.ws() + WS_YMIX);
    bool isctx; int r0, t0;
    if (tile < 512) { isctx = false; r0 = (tile >> 5) * L_ + (tile & 31) * 64; t0 = 0; }
    else { const int u = tile - 512; isctx = true; t0 = (u & 3) * 64; r0 = NLAT + (u >> 2) * LC_ + t0; }
    LAS float* zt = (LAS float*)lds;
    __syncthreads();
    {
        v4u a4[6], g4[6];
#pragma unroll
        for (int it = 0; it < 6; ++it) {
            const int i = tid + 512 * it; const int idx = i >> 5, cg = i & 31, rel = idx - 15;
            const bool valid = (i < 94 * 32) && (isctx ? (t0 + rel >= 0 && t0 + rel < LC_) : (rel >= 0 && rel < 64));
            const bf16* p = PROJ + (size_t)(r0 + rel) * NP + cg * 8;
            a4[it] = valid ? *(const v4u*)(p + PCA) : (v4u){0u, 0u, 0u, 0u};
            g4[it] = valid ? *(const v4u*)(p + PCG) : (v4u){0u, 0u, 0u, 0u};
        }
#pragma unroll
        for (int it = 0; it < 6; ++it) {
            const int i = tid + 512 * it; const int idx = i >> 5, cg = i & 31;
            if (i < 94 * 32) {
                float af[8], gf[8]; unpack8(a4[it], af); unpack8(g4[it], gf);
                float z[8];
#pragma unroll
                for (int q = 0; q < 8; ++q) z[q] = af[q] * sigm(gf[q]);
                *(LAS f32x4*)(zt + idx * 256 + cg * 8) = (f32x4){z[0], z[1], z[2], z[3]};
                *(LAS f32x4*)(zt + idx * 256 + cg * 8 + 4) = (f32x4){z[4], z[5], z[6], z[7]};
            }
        }
    }
    __syncthreads();
    const int c = tid & 255, half = tid >> 8;
    float w[31];
    const float* cw = a.in(9) + (size_t)layer * 31 * 256 + c;
#pragma unroll
    for (int j = 0; j < 31; ++j) w[j] = cw[j * 256];
    const float bias = a.in(10)[layer * 256 + c];
    float out[32];
#pragma unroll
    for (int g4 = 0; g4 < 8; ++g4) {
        float win[34];
#pragma unroll
        for (int q = 0; q < 34; ++q) win[q] = zt[(half * 32 + g4 * 4 + q) * 256 + c];
#pragma unroll
        for (int u = 0; u < 4; ++u) {
            float acc = bias;
#pragma unroll
            for (int j = 0; j < 31; ++j) acc += w[j] * win[u + j];
            out[g4 * 4 + u] = acc;
        }
    }
    __syncthreads();
#pragma unroll
    for (int tt = 0; tt < 32; ++tt) zt[(half * 32 + tt) * 256 + c] = out[tt];
    __syncthreads();
    const f32x4 lw = *(const f32x4*)(a.in(11) + layer * 256 + 4 * lane), lb = *(const f32x4*)(a.in(12) + layer * 256 + 4 * lane);
    {
        f32x4 x[8]; float s1[8], s2[8];
#pragma unroll
        for (int i = 0; i < 8; ++i) { x[i] = *(const LAS f32x4*)(zt + (wave + 8 * i) * 256 + 4 * lane); s1[i] = (x[i].x + x[i].y) + (x[i].z + x[i].w); s2[i] = (x[i].x * x[i].x + x[i].y * x[i].y) + (x[i].z * x[i].z + x[i].w * x[i].w); }
#pragma unroll
        for (int o = 1; o < 64; o <<= 1)
#pragma unroll
            for (int i = 0; i < 8; ++i) { s1[i] += __shfl_xor(s1[i], o); s2[i] += __shfl_xor(s2[i], o); }
#pragma unroll
        for (int i = 0; i < 8; ++i) {
            const float mean = s1[i] * (1.f / 256.f); const float var = fmaxf(s2[i] * (1.f / 256.f) - mean * mean, 0.f);
            const f32x4 y = (x[i] - mean) * rsqrtf(var + EPS) * lw + lb;
            const f32x4 o = (f32x4){silu(y.x), silu(y.y), silu(y.z), silu(y.w)};
            *(v2u*)(YM + (size_t)(r0 + wave + 8 * i) * D_ + 4 * lane) = pack4(o);
        }
    }
}
#define ZERO16 (f32x16){0.f,0.f,0.f,0.f,0.f,0.f,0.f,0.f,0.f,0.f,0.f,0.f,0.f,0.f,0.f,0.f}
typedef short s16x8 __attribute__((ext_vector_type(8)));
constexpr int GL_QD = 0, GL_KD = 4608, GL_FR = 9216, GL_EG = 13312, GL_SLOT = 13824;
typedef float f32x2_t __attribute__((ext_vector_type(2))); typedef __bf16 bf16x2_t __attribute__((ext_vector_type(2)));
__device__ __forceinline__ unsigned cvtpk(float lo, float hi) { f32x2_t v = {lo, hi}; bf16x2_t b = __builtin_convertvector(v, bf16x2_t); return __builtin_bit_cast(unsigned, b); }
__device__ __forceinline__ s16x8 pack8(const f32x16& x, int s) {
    v4u w; w.x = cvtpk(x[8 * s + 0], x[8 * s + 1]); w.y = cvtpk(x[8 * s + 2], x[8 * s + 3]); w.z = cvtpk(x[8 * s + 4], x[8 * s + 5]); w.w = cvtpk(x[8 * s + 6], x[8 * s + 7]);
    return __builtin_bit_cast(s16x8, w);
}
#define GL_BAR() do { asm volatile("s_waitcnt lgkmcnt(0)" ::: "memory"); __builtin_amdgcn_s_barrier(); asm volatile("" ::: "memory"); } while (0)
__device__ __forceinline__ int gla_row0(int b, int dir, int c) {
    return (c < 8) ? (NLAT + b * LC_ + (dir ? (LC_ - 1 - 32 * c) : 32 * c)) : (b * L_ + (dir ? (L_ - 1 - 32 * (c - 8)) : 32 * (c - 8)));
}
__device__ __forceinline__ void gla_fast_task(const Ctx& a, LAS unsigned char* lds, int layer, int task, int tid) {
    const int dir = task & 1, h = (task >> 1) & 3, b = task >> 3;
    const int lane = tid & 63, wave = __builtin_amdgcn_readfirstlane(tid >> 6);
    const int n = lane & 31, hh = lane >> 5;
    const bf16* PROJ = (const bf16*)(a.ws() + WS_PROJ);
    const int sgn = dir ? -1 : 1;
    __syncthreads();
    if (wave < 4) {
        const int cc = wave >> 1, dt = wave & 1;
        const int dkl = 32 * dt + n;
        const float* wa = a.in(dir ? 15 : 13) + layer * 16 * 256 + h * 64 + dkl;
        const float bav = a.in(dir ? 16 : 14)[layer * 256 + h * 64 + dkl];
        const int afoff = dir ? PAB : PAF;
        s16x8 wah, wal;
        {
            float wv[8]; unsigned hi[8], lo[8];
#pragma unroll
            for (int j = 0; j < 8; ++j) { wv[j] = wa[(8 * hh + j) * 256]; hi[j] = f2bf(wv[j]); lo[j] = f2bf(wv[j] - bf2f(hi[j])); }
            v4u wh, wl;
            wh.x = hi[0] | (hi[1] << 16); wh.y = hi[2] | (hi[3] << 16); wh.z = hi[4] | (hi[5] << 16); wh.w = hi[6] | (hi[7] << 16);
            wl.x = lo[0] | (lo[1] << 16); wl.y = lo[2] | (lo[3] << 16); wl.z = lo[4] | (lo[5] << 16); wl.w = lo[6] | (lo[7] << 16);
            wah = __builtin_bit_cast(s16x8, wh); wal = __builtin_bit_cast(s16x8, wl);
        }
        v4u afr_n; unsigned qr_n[16], kr_n[16];
        const char* Pb = (const char*)PROJ;
        const int afl = (sgn * n * NP + afoff + 8 * hh) * 2, ql = (sgn * 4 * hh * NP + PQ + h * 64 + dkl) * 2, kl = (sgn * 4 * hh * NP + PK + h * 64 + dkl) * 2;
        {
            const char* prow = Pb + (size_t)gla_row0(b, dir, cc) * (NP * 2);
            afr_n = *(const v4u*)(prow + afl);
#pragma unroll
            for (int r = 0; r < 16; ++r) { const int ro = sgn * ((r & 3) + 8 * (r >> 2)) * (NP * 2); qr_n[r] = *(const bf16*)(prow + (ql + ro)); kr_n[r] = *(const bf16*)(prow + (kl + ro)); }
        }
        for (int i = 0; i <= 36; ++i) {
            if (i < 36) {
                LAS unsigned char* sl = lds + ((i & 1) * 2 + cc) * GL_SLOT;
                const v4u afr = afr_n; unsigned qr[16], kr[16];
#pragma unroll
                for (int r = 0; r < 16; ++r) { qr[r] = qr_n[r]; kr[r] = kr_n[r]; }
                if (i + 1 < 36) {
                    const char* prow = Pb + (size_t)gla_row0(b, dir, 2 * (i + 1) + cc) * (NP * 2);
                    afr_n = *(const v4u*)(prow + afl);
#pragma unroll
                    for (int r = 0; r < 16; ++r) { const int ro = sgn * ((r & 3) + 8 * (r >> 2)) * (NP * 2); qr_n[r] = *(const bf16*)(prow + (ql + ro)); kr_n[r] = *(const bf16*)(prow + (kl + ro)); }
                }
                f32x16 Z = ZERO16;
                Z = __builtin_amdgcn_mfma_f32_32x32x16_bf16(__builtin_bit_cast(s16x8, afr), wah, Z, 0, 0, 0);
                Z = __builtin_amdgcn_mfma_f32_32x32x16_bf16(__builtin_bit_cast(s16x8, afr), wal, Z, 0, 0, 0);
                float p[16];
#pragma unroll
                for (int r = 0; r < 16; ++r) { const float z = Z[r] + bav; p[r] = fminf(z, 0.f) * (1.f / 16.f) - __builtin_amdgcn_logf(1.f + __builtin_amdgcn_exp2f(-1.4426950408889634f * fabsf(z))) * (0.6931471805599453f / 16.f); }
                float G[4], Gp[4];
#pragma unroll
                for (int g = 0; g < 4; ++g) { p[4 * g + 1] += p[4 * g]; p[4 * g + 2] += p[4 * g + 1]; p[4 * g + 3] += p[4 * g + 2]; G[g] = p[4 * g + 3]; }
#pragma unroll
                for (int g = 0; g < 4; ++g) Gp[g] = __shfl_xor(G[g], 32);
                float off = 0.f;
#pragma unroll
                for (int g = 0; g < 4; ++g) {
                    const float o_g = off + (hh ? Gp[g] : 0.f);
#pragma unroll
                    for (int q = 0; q < 4; ++q) p[4 * g + q] += o_g;
                    off += G[g] + Gp[g];
                }
                f32x16 kd;
#pragma unroll
                for (int r = 0; r < 16; ++r) {
                    const int t = (r & 3) + 8 * (r >> 2) + 4 * hh;
                    const float E = __builtin_amdgcn_exp2f(p[r] * 1.4426950408889634f);
                    const float qd = bf2f(qr[r]) * 0.125f * E; const float kdv = bf2f(kr[r]) * __builtin_amdgcn_rcpf(E);
                    kd[r] = kdv;
                    const unsigned qk = cvtpk(qd, kdv);
                    *(LAS unsigned short*)(sl + GL_QD + t * 144 + dkl * 2) = (unsigned short)(qk & 0xffffu);
                    *(LAS unsigned short*)(sl + GL_KD + t * 144 + dkl * 2) = (unsigned short)(qk >> 16);
                }
                *(LAS s16x8*)(sl + GL_FR + ((dt * 2 + 0) * 64 + lane) * 16) = pack8(kd, 0);
                *(LAS s16x8*)(sl + GL_FR + ((dt * 2 + 1) * 64 + lane) * 16) = pack8(kd, 1);
                if (hh == 0) *(LAS float*)(sl + GL_EG + dkl * 4) = __builtin_amdgcn_exp2f(off * 1.4426950408889634f);
            }
            GL_BAR();
        }
    } else {
        const int n0 = 32 * (wave - 4);
        const char* Vb = (const char*)(PROJ + PV + h * 128 + n0);
        char* Ob = (char*)((bf16*)(a.ws() + WS_OGLA) + (size_t)dir * MT * 512 + h * 128 + n0);
        const int vl = (sgn * 4 * hh * NP + n) * 2, ol = (sgn * 4 * hh * 512 + n) * 2;
        f32x16 S0 = ZERO16, S1 = ZERO16;
        unsigned vr_n[2][16];
#pragma unroll
        for (int cc = 0; cc < 2; ++cc)
#pragma unroll
            for (int r = 0; r < 16; ++r) vr_n[cc][r] = 0u;
        for (int i = 0; i <= 36; ++i) {
            unsigned vr[2][16];
#pragma unroll
            for (int cc = 0; cc < 2; ++cc)
#pragma unroll
                for (int r = 0; r < 16; ++r) vr[cc][r] = vr_n[cc][r];
            if (i < 36) {
#pragma unroll
                for (int cc = 0; cc < 2; ++cc) {
                    const char* vrow = Vb + (size_t)gla_row0(b, dir, 2 * i + cc) * (NP * 2);
#pragma unroll
                    for (int r = 0; r < 16; ++r) vr_n[cc][r] = *(const bf16*)(vrow + (vl + sgn * ((r & 3) + 8 * (r >> 2)) * (NP * 2)));
                }
            }
            if (i >= 1) {
                const LAS unsigned char* slb = lds + ((i - 1) & 1) * 2 * GL_SLOT;
                s16x8 vb[2][2];
#pragma unroll
                for (int cc = 0; cc < 2; ++cc)
#pragma unroll
                    for (int s2 = 0; s2 < 2; ++s2) {
                        v4u w; w.x = vr[cc][8 * s2 + 0] | (vr[cc][8 * s2 + 1] << 16); w.y = vr[cc][8 * s2 + 2] | (vr[cc][8 * s2 + 3] << 16);
                        w.z = vr[cc][8 * s2 + 4] | (vr[cc][8 * s2 + 5] << 16); w.w = vr[cc][8 * s2 + 6] | (vr[cc][8 * s2 + 7] << 16);
                        vb[cc][s2] = __builtin_bit_cast(s16x8, w);
                    }
                f32x16 o[2];
#pragma unroll
                for (int cc = 0; cc < 2; ++cc) {
                    const LAS unsigned char* sl = slb + cc * GL_SLOT;
                    f32x16 PT = ZERO16;
#pragma unroll
                    for (int s4 = 0; s4 < 4; ++s4) {
                        const s16x8 ak = *(const LAS s16x8*)(sl + GL_KD + n * 144 + (16 * s4 + 8 * hh) * 2);
                        const s16x8 bq = *(const LAS s16x8*)(sl + GL_QD + n * 144 + (16 * s4 + 8 * hh) * 2);
                        PT = __builtin_amdgcn_mfma_f32_32x32x16_bf16(ak, bq, PT, 0, 0, 0);
                    }
#pragma unroll
                    for (int r = 0; r < 16; ++r) { const int j = (r & 3) + 8 * (r >> 2) + 4 * hh; PT[r] = (j <= n) ? PT[r] : 0.f; }
                    o[cc] = ZERO16;
                    o[cc] = __builtin_amdgcn_mfma_f32_32x32x16_bf16(pack8(PT, 0), vb[cc][0], o[cc], 0, 0, 0);
                    o[cc] = __builtin_amdgcn_mfma_f32_32x32x16_bf16(pack8(PT, 1), vb[cc][1], o[cc], 0, 0, 0);
                }
#pragma unroll
                for (int cc = 0; cc < 2; ++cc) {
                    const int c = 2 * (i - 1) + cc;
                    const LAS unsigned char* sl = slb + cc * GL_SLOT;
                    f32x16 d0 = ZERO16, d1 = ZERO16;
#pragma unroll
                    for (int s2 = 0; s2 < 2; ++s2) {
                        d0 = __builtin_amdgcn_mfma_f32_32x32x16_bf16(*(const LAS s16x8*)(sl + GL_FR + ((0 * 2 + s2) * 64 + lane) * 16), vb[cc][s2], d0, 0, 0, 0);
                        d1 = __builtin_amdgcn_mfma_f32_32x32x16_bf16(*(const LAS s16x8*)(sl + GL_FR + ((1 * 2 + s2) * 64 + lane) * 16), vb[cc][s2], d1, 0, 0, 0);
                    }
#pragma unroll
                    for (int dt = 0; dt < 2; ++dt)
#pragma unroll
                        for (int s2 = 0; s2 < 2; ++s2) {
                            const v2u a0 = *(const LAS v2u*)(sl + GL_QD + n * 144 + (32 * dt + 16 * s2 + 4 * hh) * 2);
                            const v2u a1 = *(const LAS v2u*)(sl + GL_QD + n * 144 + (32 * dt + 16 * s2 + 8 + 4 * hh) * 2);
                            const v4u aw = (v4u){a0.x, a0.y, a1.x, a1.y};
                            o[cc] = __builtin_amdgcn_mfma_f32_32x32x16_bf16(__builtin_bit_cast(s16x8, aw), pack8(dt ? S1 : S0, s2), o[cc], 0, 0, 0);
                        }
#pragma unroll
                    for (int g = 0; g < 4; ++g) {
                        const f32x4 e0 = *(const LAS f32x4*)(sl + GL_EG + (8 * g + 4 * hh) * 4), e1 = *(const LAS f32x4*)(sl + GL_EG + (32 + 8 * g + 4 * hh) * 4);
                        S0[4 * g + 0] = e0.x * (S0[4 * g + 0] + d0[4 * g + 0]); S0[4 * g + 1] = e0.y * (S0[4 * g + 1] + d0[4 * g + 1]);
                        S0[4 * g + 2] = e0.z * (S0[4 * g + 2] + d0[4 * g + 2]); S0[4 * g + 3] = e0.w * (S0[4 * g + 3] + d0[4 * g + 3]);
                        S1[4 * g + 0] = e1.x * (S1[4 * g + 0] + d1[4 * g + 0]); S1[4 * g + 1] = e1.y * (S1[4 * g + 1] + d1[4 * g + 1]);
                        S1[4 * g + 2] = e1.z * (S1[4 * g + 2] + d1[4 * g + 2]); S1[4 * g + 3] = e1.w * (S1[4 * g + 3] + d1[4 * g + 3]);
                    }
                    if (!(layer == 1 && c < 8)) {
                        char* orow = Ob + (size_t)gla_row0(b, dir, c) * (512 * 2);
#pragma unroll
                        for (int r = 0; r < 16; ++r) *(bf16*)(orow + (ol + sgn * ((r & 3) + 8 * (r >> 2)) * (512 * 2))) = (bf16)(cvtpk(o[cc][r], o[cc][r]) & 0xffffu);
                    }
                }
            }
            GL_BAR();
        }
    }
    asm volatile("s_waitcnt vmcnt(0)" ::: "memory");
    __syncthreads();
}
__device__ __forceinline__ void p_mix(const Ctx& a, LAS unsigned char* lds, int layer, int tid) {
    const int G = gridDim.x;
    if (G >= 256) {
#ifndef MIXREP_GLA
#define MIXREP_GLA 1
#endif
#ifndef MIXREP_CONF
#define MIXREP_CONF 1
#endif
#ifndef MIXREP_SC
#define MIXREP_SC 1
#endif
        if ((int)blockIdx.x < 128) { for (int rp = 0; rp < MIXREP_GLA; ++rp) gla_fast_task(a, lds, layer, blockIdx.x, tid); return; }
        const int cb = blockIdx.x - 128, ncb = G - 128;
        const int ntile = (layer == 0) ? 576 : 512;
        for (int rp = 0; rp < MIXREP_CONF; ++rp) for (int t = cb; t < ntile; t += ncb) conf_tile(a, lds, layer, t, tid);
        for (int rp = 0; rp < MIXREP_SC; ++rp) p_shortconv(a, layer, tid, cb, ncb);
        return;
    }
    for (int t = blockIdx.x; t < 128; t += G) gla_fast_task(a, lds, layer, t, tid);
    const int ntile = (layer == 0) ? 576 : 512;
    for (int t = blockIdx.x; t < ntile; t += gridDim.x) conf_tile(a, lds, layer, t, tid);
    p_shortconv(a, layer, tid, blockIdx.x, gridDim.x);
}
__device__ __forceinline__ void p_glaout(const Ctx& a, int layer, int tid) {
    const int lane = tid & 63, wave = tid >> 6, gw = blockIdx.x * NWAVES + wave, NGW = gridDim.x * NWAVES;
    const bf16* PROJ = (const bf16*)(a.ws() + WS_PROJ); bf16* YM = (bf16*)(a.ws() + WS_YMIX);
    const bf16* OG0 = (const bf16*)(a.ws() + WS_OGLA); const bf16* OG1 = OG0 + (size_t)MT * 512;
    const int nrows = (layer == 0) ? MT : NLAT;
    const float* gn = a.in(17) + layer * 512 + 8 * lane;
    const f32x4 g0 = *(const f32x4*)gn, g1 = *(const f32x4*)(gn + 4);
    const float gv[8] = {g0.x, g0.y, g0.z, g0.w, g1.x, g1.y, g1.z, g1.w};
    for (int row = gw; row < nrows; row += NGW) {
        const v4u f4 = *(const v4u*)(OG0 + (size_t)row * 512 + 8 * lane), b4 = *(const v4u*)(OG1 + (size_t)row * 512 + 8 * lane);
        const v4u r4 = *(const v4u*)(PROJ + (size_t)row * NP + PR + 8 * lane);
        const unsigned fw[4] = {f4.x, f4.y, f4.z, f4.w}, bw[4] = {b4.x, b4.y, b4.z, b4.w}, rw[4] = {r4.x, r4.y, r4.z, r4.w};
        float o[8], r[8]; float ss = 0.f;
#pragma unroll
        for (int q = 0; q < 4; ++q) {
            o[2 * q] = bf2f(fw[q] & 0xffffu) + bf2f(bw[q] & 0xffffu); o[2 * q + 1] = bf2f(fw[q] >> 16) + bf2f(bw[q] >> 16);
            r[2 * q] = bf2f(rw[q] & 0xffffu); r[2 * q + 1] = bf2f(rw[q] >> 16);
            ss += o[2 * q] * o[2 * q] + o[2 * q + 1] * o[2 * q + 1];
        }
        ss += __shfl_xor(ss, 1); ss += __shfl_xor(ss, 2); ss += __shfl_xor(ss, 4); ss += __shfl_xor(ss, 8);
        const float rstd = rsqrtf(ss * (1.f / 128.f) + EPS);
        float y[8];
#pragma unroll
        for (int q = 0; q < 8; ++q) y[q] = o[q] * rstd * gv[q] * silu(r[q]);
        v4u w; w.x = pk2(y[0], y[1]); w.y = pk2(y[2], y[3]); w.z = pk2(y[4], y[5]); w.w = pk2(y[6], y[7]);
        *(v4u*)(YM + (size_t)row * D_ + 256 + 8 * lane) = w;
    }
}

namespace pg8 {
#define PG8_LAS __attribute__((address_space(3)))
typedef unsigned short bf16_t;
typedef short bf16x8 __attribute__((ext_vector_type(8)));
typedef float f32x4 __attribute__((ext_vector_type(4)));
typedef unsigned u32x4 __attribute__((ext_vector_type(4)));
constexpr int BM = 256, BK = 64, HALF = 128, HTB = HALF * BK * 2  , STAGE_BYTES = 8 * HTB, NXCD = 8, WGM = 8;

__host__ __device__ __forceinline__ int lds_byte(int r, int c) { const int st = (r >> 4) * 2 + (c >> 5), rr = r & 15, cc = c & 31, ob = rr * 64 + cc * 2; return st * 1024 + (ob ^ (((ob >> 9) & 1) << 5)); }
__host__ __device__ __forceinline__ void stage_rc(int b, int& R, int& C) { const int st = b / 1024, sb = b % 1024, swz = sb ^ (((sb >> 9) & 1) << 5); R = (st >> 1) * 16 + swz / 64; C = (st & 1) * 32 + (swz % 64) / 2; }
__host__ __device__ __forceinline__ int perm32(int rho) { const int n = rho >> 4, i = rho & 15; return 8 * (i >> 2) + 4 * n + (i & 3); }

struct Unit { int pm, pn, ui; };
struct Gemm { const bf16_t* A; const bf16_t* Bt; int M, N, K; };

struct StaticOrder {
    int nM, nN, nwg, G, c;
    __host__ __device__ void init(int M, int N, int G_, int c_) { nM = M / BM; nN = N / BM; nwg = nM * nN; G = G_; c = c_; }
    __host__ __device__ bool next(int i, Unit& u) const {
        const long L = (long)i * G + c; if (L >= nwg) return false;
        int wgid = (int)L; { const int q = nwg / NXCD, r = nwg % NXCD, xcd = wgid % NXCD, off = wgid / NXCD; wgid = (xcd < r ? xcd * (q + 1) : r * (q + 1) + (xcd - r) * q) + off; }
        const int nig = WGM * nN, gid = wgid / nig, fm = gid * WGM, gsz = (nM - fm) < WGM ? (nM - fm) : WGM;
        u.pm = fm + ((wgid % nig) % gsz); u.pn = (wgid % nig) / gsz; u.ui = i; return true;
    }
    __device__ __forceinline__ void a_ready(const Unit&) const {}
    __device__ __forceinline__ void done(const Unit&) const {}
};


typedef float f32x2c_t __attribute__((ext_vector_type(2))); typedef __bf16 bf16x2c_t __attribute__((ext_vector_type(2)));
__device__ __forceinline__ unsigned cvt_pk_bf16(float lo, float hi) { f32x2c_t v = {lo, hi}; bf16x2c_t b = __builtin_convertvector(v, bf16x2c_t); return __builtin_bit_cast(unsigned, b); }
template <class Epi, class Sched, bool ALIGN_EPI = false, bool SP2 = false, bool FP8 = false>
__device__ __forceinline__ void gemm_phase(PG8_LAS unsigned char* lds, const Gemm g, const Sched& S, const Epi& E) {
    const int tid = otid(), wid = __builtin_amdgcn_readfirstlane(tid >> 6), lane = tid & 63, wr = wid >> 2, wc = wid & 3, fr = lane & 15, fq = lane >> 4;
    const int K = g.K, nt = K / BK;
    unsigned voffA[2], voffB[2];
#pragma unroll
    for (int i = 0; i < 2; ++i) { int R, C; stage_rc(tid * 16 + i * 8192, R, C); const int Rb = Epi::PERM ? ((R & ~31) + perm32(R & 31)) : R;
        voffA[i] = (unsigned)(R * K + C) * 2u; voffB[i] = (unsigned)(Rb * K + C) * 2u; }
    static_assert(!Sched::GATHER || SP2, "the gathered-A variant is written for the SP2 loop");
    unsigned gA0[2] = {0u, 0u}, gA1[2] = {0u, 0u}, ngA0[2] = {0u, 0u}, ngA1[2] = {0u, 0u};
#define PG8_GOFF(uix, o0, o1) do { _Pragma("unroll") for (int _i = 0; _i < 2; ++_i) { int R_, C_; stage_rc(tid * 16 + _i * 8192, R_, C_); \
        (o0)[_i] = (unsigned)S.arow((uix), R_) * (unsigned)(K * 2) + (unsigned)(C_ * 2); (o1)[_i] = (unsigned)S.arow((uix), HALF + R_) * (unsigned)(K * 2) + (unsigned)(C_ * 2); } } while (0)
#define PG8_STAGE_A0(bufoff, ptr, arr) do { if constexpr (Sched::GATHER) PG8_STAGE(bufoff, ptr, arr); else PG8_STAGE(bufoff, ptr, voffA); } while (0)
#define PG8_STAGE_A1(bufoff, ptr, arr) do { if constexpr (Sched::GATHER) PG8_STAGE(bufoff, ptr, arr); else PG8_STAGE(bufoff, (ptr) + hstep, voffA); } while (0)
    const size_t kstep = (size_t)(BK * 2);
    const size_t hstep = (size_t)HALF * K * 2;
    const size_t tstep = 2 * hstep;
    const unsigned ldsw = (unsigned)wid * 1024u;
    const int aoff = lds_byte(wr * 64 + fr, fq * 8), boff = lds_byte(wc * 32 + fr, fq * 8);
#define PG8_SA(b, h) (((b) * 2 + (h)) * HTB)
#define PG8_SB(b, h) ((4 + (b) * 2 + (h)) * HTB)
#define PG8_STAGE(bufoff, gbase, voff) do { _Pragma("unroll") for (int _i = 0; _i < 2; ++_i) \
        __builtin_amdgcn_global_load_lds((const unsigned*)((const char*)(gbase) + (voff)[_i]), (PG8_LAS unsigned*)(lds + (bufoff) + ldsw + _i * 8192), 16, 0, 0); } while (0)
#define PG8_LDA(dst, b, h) do { _Pragma("unroll") for (int m = 0; m < 4; ++m) { if constexpr (FP8) dst##8[m] = PG8_CAT8(*(const PG8_LAS bf16x8*)(lds + PG8_SA(b, h) + aoff + m * 2048), *(const PG8_LAS bf16x8*)(lds + PG8_SA(b, h) + aoff + m * 2048 + 1024)); \
        else { _Pragma("unroll") for (int k = 0; k < 2; ++k) dst[m][k] = *(const PG8_LAS bf16x8*)(lds + PG8_SA(b, h) + aoff + m * 2048 + k * 1024); } } } while (0)
#define PG8_LDB(dst, b, h) do { _Pragma("unroll") for (int n = 0; n < 2; ++n) { if constexpr (FP8) dst##8[n] = PG8_CAT8(*(const PG8_LAS bf16x8*)(lds + PG8_SB(b, h) + boff + n * 2048), *(const PG8_LAS bf16x8*)(lds + PG8_SB(b, h) + boff + n * 2048 + 1024)); \
        else { _Pragma("unroll") for (int k = 0; k < 2; ++k) dst[n][k] = *(const PG8_LAS bf16x8*)(lds + PG8_SB(b, h) + boff + n * 2048 + k * 1024); } } } while (0)
typedef int v8i_t __attribute__((ext_vector_type(8)));
typedef int v4i_t __attribute__((ext_vector_type(4)));
#define PG8_CAT8(x0, x1) __builtin_shufflevector(__builtin_bit_cast(v4i_t, (x0)), __builtin_bit_cast(v4i_t, (x1)), 0, 1, 2, 3, 4, 5, 6, 7)
#define PG8_MMA(ai, bj, At, Bt) do { __builtin_amdgcn_s_setprio(1); _Pragma("unroll") for (int m = 0; m < 4; ++m) _Pragma("unroll") for (int n = 0; n < 2; ++n) { \
        if constexpr (FP8) asm volatile("v_mfma_f32_16x16x128_f8f6f4 %0, %1, %2, %0" : "+v"(acc[ai][bj][m][n]) : "v"(Bt##8[n]), "v"(At##8[m])); \
        else { _Pragma("unroll") for (int k = 0; k < 2; ++k) acc[ai][bj][m][n] = __builtin_amdgcn_mfma_f32_16x16x32_bf16(Bt[n][k], At[m][k], acc[ai][bj][m][n], 0, 0, 0); } } \
        __builtin_amdgcn_s_setprio(0); } while (0)
#define PG8_WAIT_V(n) asm volatile("s_waitcnt vmcnt(" #n ")" ::: "memory")
#define PG8_WAIT_L(n) asm volatile("s_waitcnt lgkmcnt(" #n ")" ::: "memory")
#define PG8_BAR __builtin_amdgcn_s_barrier()
#define PG8_SCHED __builtin_amdgcn_sched_barrier(0)
    Unit cur, nxt; int ui = 0;
    if (!S.next(0, cur)) return;
    f32x4 acc[2][2][4][2];
#pragma unroll
    for (int a = 0; a < 2; ++a)
#pragma unroll
        for (int b = 0; b < 2; ++b)
#pragma unroll
            for (int m = 0; m < 4; ++m)
#pragma unroll
                for (int n = 0; n < 2; ++n) acc[a][b][m][n] = (f32x4){0.f, 0.f, 0.f, 0.f};
    bf16x8 At[4][2], B0[2][2], B1[2][2];
    v8i_t At8[4], B08[2], B18[2];
    const char* cA = Sched::GATHER ? (const char*)g.A : (const char*)g.A + (size_t)cur.pm * tstep; const char* cB = (const char*)g.Bt + (size_t)cur.pn * tstep;
    if constexpr (Sched::GATHER) PG8_GOFF(0, gA0, gA1);
    S.a_ready(cur);
    if constexpr (SP2) {
        PG8_STAGE(PG8_SB(0, 0), cB, voffB); PG8_STAGE(PG8_SB(0, 1), cB + hstep, voffB); PG8_STAGE_A0(PG8_SA(0, 0), cA, gA0); PG8_STAGE_A1(PG8_SA(0, 1), cA, gA1);
        if (wr == 1) PG8_BAR;
        PG8_WAIT_V(2); PG8_BAR;
        PG8_STAGE(PG8_SB(1, 0), cB + kstep, voffB); PG8_STAGE_A0(PG8_SA(1, 0), cA + kstep, gA0); PG8_STAGE(PG8_SB(1, 1), cB + hstep + kstep, voffB);
        PG8_WAIT_V(6); PG8_BAR;
    } else {
        PG8_STAGE(PG8_SB(0, 0), cB, voffB); PG8_STAGE(PG8_SA(0, 0), cA, voffA); PG8_STAGE(PG8_SB(0, 1), cB + hstep, voffB); PG8_STAGE(PG8_SA(0, 1), cA + hstep, voffA);
        if (wr == 1) PG8_BAR;
        PG8_WAIT_V(4); PG8_BAR;
        PG8_STAGE(PG8_SB(1, 0), cB + kstep, voffB); PG8_STAGE(PG8_SA(1, 0), cA + kstep, voffA); PG8_STAGE(PG8_SB(1, 1), cB + hstep + kstep, voffB);
        PG8_WAIT_V(6); PG8_BAR;
    }
    for (;;) {
        const bool has_next = S.next(ui + 1, nxt);
        const char* nA = (has_next && !Sched::GATHER) ? (const char*)g.A + (size_t)nxt.pm * tstep : cA; const char* nB = has_next ? (const char*)g.Bt + (size_t)nxt.pn * tstep : cB;
        if constexpr (Sched::GATHER) { if (has_next) PG8_GOFF(ui + 1, ngA0, ngA1); else { ngA0[0] = gA0[0]; ngA0[1] = gA0[1]; ngA1[0] = gA1[0]; ngA1[1] = gA1[1]; } }
#pragma unroll 1
        for (int t = 0; t < nt; t += 2) {
            const bool last = (t == nt - 2);
            const char* a1 = cA + (size_t)(t + 1) * kstep;
            const char* a2 = last ? nA : cA + (size_t)(t + 2) * kstep; const char* b2 = last ? nB : cB + (size_t)(t + 2) * kstep;
            const char* a3 = a2 + kstep; const char* b3 = b2 + kstep;
            if (last && has_next) S.a_ready(nxt);
            unsigned xA0[2], xA1[2];
            xA0[0] = last ? ngA0[0] : gA0[0]; xA0[1] = last ? ngA0[1] : gA0[1]; xA1[0] = last ? ngA1[0] : gA1[0]; xA1[1] = last ? ngA1[1] : gA1[1];
            if constexpr (SP2) {
            PG8_LDB(B0, 0, 0); PG8_LDB(B1, 0, 1); PG8_SCHED; PG8_LDA(At, 0, 0); PG8_STAGE_A1(PG8_SA(1, 1), a1, gA1);
            PG8_WAIT_V(8); PG8_WAIT_L(0); PG8_BAR; PG8_MMA(0, 0, At, B0); PG8_MMA(0, 1, At, B1); PG8_BAR; PG8_SCHED;
            PG8_LDA(At, 0, 1); PG8_STAGE(PG8_SB(0, 0), b2, voffB); PG8_STAGE(PG8_SB(0, 1), b2 + hstep, voffB); PG8_STAGE_A0(PG8_SA(0, 0), a2, xA0);
            PG8_WAIT_V(8); PG8_WAIT_L(0); PG8_BAR; PG8_MMA(1, 0, At, B0); PG8_MMA(1, 1, At, B1); PG8_BAR; PG8_SCHED;
            PG8_LDB(B0, 1, 0); PG8_LDB(B1, 1, 1); PG8_SCHED; PG8_LDA(At, 1, 0); PG8_STAGE_A1(PG8_SA(0, 1), a2, xA1);
            PG8_WAIT_V(8); PG8_WAIT_L(0); PG8_BAR; PG8_MMA(0, 0, At, B0); PG8_MMA(0, 1, At, B1); PG8_BAR; PG8_SCHED;
            PG8_LDA(At, 1, 1); PG8_STAGE(PG8_SB(1, 0), b3, voffB); PG8_STAGE(PG8_SB(1, 1), b3 + hstep, voffB); PG8_STAGE_A0(PG8_SA(1, 0), a3, xA0);
            PG8_WAIT_V(8); PG8_WAIT_L(0); PG8_BAR; PG8_MMA(1, 0, At, B0); PG8_MMA(1, 1, At, B1); PG8_BAR; PG8_SCHED;
            } else {
            PG8_LDB(B0, 0, 0); PG8_SCHED; PG8_LDA(At, 0, 0); PG8_STAGE(PG8_SA(1, 1), a1 + hstep, voffA);
            PG8_WAIT_L(8); PG8_BAR; PG8_WAIT_L(0); PG8_MMA(0, 0, At, B0); PG8_BAR; PG8_SCHED;
            PG8_LDB(B1, 0, 1); PG8_STAGE(PG8_SB(0, 0), b2, voffB);
            PG8_BAR; PG8_WAIT_L(0); PG8_MMA(0, 1, At, B1); PG8_BAR;
            PG8_LDA(At, 0, 1); PG8_STAGE(PG8_SA(0, 0), a2, voffA);
            PG8_BAR; PG8_WAIT_L(0); PG8_MMA(1, 0, At, B0); PG8_BAR; PG8_SCHED;
            PG8_STAGE(PG8_SB(0, 1), b2 + hstep, voffB);
            PG8_WAIT_V(6); PG8_BAR; PG8_MMA(1, 1, At, B1); PG8_BAR;
            PG8_LDB(B0, 1, 0); PG8_SCHED; PG8_LDA(At, 1, 0); PG8_STAGE(PG8_SA(0, 1), a2 + hstep, voffA);
            PG8_WAIT_L(8); PG8_BAR; PG8_WAIT_L(0); PG8_MMA(0, 0, At, B0); PG8_BAR; PG8_SCHED;
            PG8_LDB(B1, 1, 1); PG8_STAGE(PG8_SB(1, 0), b3, voffB);
            PG8_BAR; PG8_WAIT_L(0); PG8_MMA(0, 1, At, B1); PG8_BAR;
            PG8_LDA(At, 1, 1); PG8_STAGE(PG8_SA(1, 0), a3, voffA);
            PG8_BAR; PG8_WAIT_L(0); PG8_MMA(1, 0, At, B0); PG8_BAR; PG8_SCHED;
            PG8_STAGE(PG8_SB(1, 1), b3 + hstep, voffB);
            PG8_WAIT_V(6); PG8_BAR; PG8_MMA(1, 1, At, B1); PG8_BAR;
            }
        }
        if constexpr (FP8) asm volatile("s_nop 15\n\ts_nop 15" ::: "memory");
        if constexpr (ALIGN_EPI) { if (wr == 0) PG8_BAR; }
        if constexpr (!Epi::AFTER_DRAIN) { E(acc, cur, wr, wc, fr, fq); S.done(cur); }
        if (!has_next) break;
#pragma unroll
        for (int a = 0; a < 2; ++a)
#pragma unroll
            for (int b = 0; b < 2; ++b)
#pragma unroll
                for (int m = 0; m < 4; ++m)
#pragma unroll
                    for (int n = 0; n < 2; ++n) acc[a][b][m][n] = (f32x4){0.f, 0.f, 0.f, 0.f};
        cur = nxt; cA = nA; cB = nB; ++ui;
        if constexpr (Sched::GATHER) { gA0[0] = ngA0[0]; gA0[1] = ngA0[1]; gA1[0] = ngA1[0]; gA1[1] = ngA1[1]; }
        if constexpr (ALIGN_EPI) { if (wr == 1) PG8_BAR; }
    }
    PG8_WAIT_V(0);
    if constexpr (!ALIGN_EPI) { if (wr == 0) PG8_BAR; }
    PG8_BAR;
    if constexpr (Epi::AFTER_DRAIN) { E.fused(acc, cur, wr, wc, fr, fq, lds, wid, lane); S.done(cur); }
#undef PG8_SA
#undef PG8_SB
#undef PG8_STAGE
#undef PG8_STAGE_A0
#undef PG8_STAGE_A1
#undef PG8_GOFF
#undef PG8_LDA
#undef PG8_LDB
#undef PG8_MMA
#undef PG8_CAT8
#undef PG8_WAIT_V
#undef PG8_WAIT_L
#undef PG8_BAR
#undef PG8_SCHED
}
}

#ifndef ST_POL
#define ST_POL 0
#endif
namespace pg8 {
__device__ __forceinline__ void gst16(void* p, u32x4 v) {
#if ST_POL == 0
    *(u32x4*)p = v;
#elif ST_POL == 1
    asm volatile("global_store_dwordx4 %0, %1, off sc1" :: "v"(p), "v"(v) : "memory");
#elif ST_POL == 2
    asm volatile("global_store_dwordx4 %0, %1, off nt" :: "v"(p), "v"(v) : "memory");
#else
    asm volatile("global_store_dwordx4 %0, %1, off sc1 nt" :: "v"(p), "v"(v) : "memory");
#endif
}
typedef unsigned u32x2e_t __attribute__((ext_vector_type(2)));
__device__ __forceinline__ void gst8(void* p, u32x2e_t v) {
#if ST_POL == 0
    *(u32x2e_t*)p = v;
#elif ST_POL == 1
    asm volatile("global_store_dwordx2 %0, %1, off sc1" :: "v"(p), "v"(v) : "memory");
#elif ST_POL == 2
    asm volatile("global_store_dwordx2 %0, %1, off nt" :: "v"(p), "v"(v) : "memory");
#else
    asm volatile("global_store_dwordx2 %0, %1, off sc1 nt" :: "v"(p), "v"(v) : "memory");
#endif
}
}
namespace pg8 {
__device__ __forceinline__ void map_tile(int wgid, int nM, int nN, int& pm, int& pn) {
    const int nwg = nM * nN;
    { const int q = nwg / NXCD, r = nwg % NXCD, xcd = wgid % NXCD, off = wgid / NXCD; wgid = (xcd < r ? xcd * (q + 1) : r * (q + 1) + (xcd - r) * q) + off; }
    const int nig = WGM * nN, gid = wgid / nig, fm = gid * WGM, gsz = (nM - fm) < WGM ? (nM - fm) : WGM;
    pm = fm + ((wgid % nig) % gsz); pn = (wgid % nig) / gsz;
}
struct DenseOrder2 {
    static constexpr bool GATHER = false;
    __device__ __forceinline__ int arow(int, int) const { return 0; }
    int nM1, nN1, nM2, nN2, pm0_2, G, c;
    __device__ __forceinline__ bool next(int i, Unit& u) const {
        const int L = i * G + c; const int n1 = nM1 * nN1, n2 = nM2 * nN2;
        if (L >= n1 + n2) return false;
        if (L < n1) map_tile(L, nM1, nN1, u.pm, u.pn); else { map_tile(L - n1, nM2, nN2, u.pm, u.pn); u.pm += pm0_2; }
        u.ui = i; return true;
    }
    __device__ __forceinline__ void a_ready(const Unit&) const {}
    __device__ __forceinline__ void done(const Unit&) const {}
};
struct GroupedOrder {
    static constexpr bool GATHER = false;
    __device__ __forceinline__ int arow(int, int) const { return 0; }
    int te, NT, G, c;
    __device__ __forceinline__ bool next(int i, Unit& u) const {
        const int L = i * G + c; const int nM = 16 * te;
        if (L >= nM * NT) return false;
        int pmv, pnv; map_tile(L, nM, NT, pmv, pnv);
        const int e = pmv / te; u.pm = e * 18 + (pmv - e * te); u.pn = e * NT + pnv; u.ui = i; return true;
    }
    __device__ __forceinline__ void a_ready(const Unit&) const {}
    __device__ __forceinline__ void done(const Unit&) const {}
};
struct GatherOrder : GroupedOrder {
    static constexpr bool GATHER = true;
    const PG8_LAS int* ridx;
    __device__ __forceinline__ int arow(int ui, int r) const { return ridx[ui * 256 + r]; }
};
struct EpiProj {
    static constexpr bool PERM = true, AFTER_DRAIN = false;
    bf16_t* O;
#ifdef PROBE_NOSTORE
    int skip;
#endif
    __device__ __forceinline__ void operator()(const f32x4 (&acc)[2][2][4][2], const Unit& u, int wr, int wc, int fr, int fq) const {
        const int row0 = u.pm * BM + wr * 64 + fr, col0 = u.pn * BM + wc * 32 + 8 * fq;
#pragma unroll
        for (int ai = 0; ai < 2; ++ai)
#pragma unroll
            for (int m = 0; m < 4; ++m) { bf16_t* rowp = O + (size_t)(row0 + ai * HALF + m * 16) * NP + col0;
#pragma unroll
                for (int bj = 0; bj < 2; ++bj) { const f32x4 v0 = acc[ai][bj][m][0], v1 = acc[ai][bj][m][1];
                    u32x4 w; w.x = cvt_pk_bf16(v0[0], v0[1]); w.y = cvt_pk_bf16(v0[2], v0[3]); w.z = cvt_pk_bf16(v1[0], v1[1]); w.w = cvt_pk_bf16(v1[2], v1[3]);
#ifdef PROBE_NOSTORE
                    if (!skip)
#endif
                    gst16(rowp + bj * HALF, w); } }
    }
};
struct EpiY {
    static constexpr bool PERM = true, AFTER_DRAIN = false;
    bf16_t* O;
    __device__ __forceinline__ void operator()(const f32x4 (&acc)[2][2][4][2], const Unit& u, int wr, int wc, int fr, int fq) const {
        const int row0 = u.pm * BM + wr * 64 + fr, col0 = u.pn * BM + wc * 32 + 8 * fq;
#pragma unroll
        for (int ai = 0; ai < 2; ++ai)
#pragma unroll
            for (int m = 0; m < 4; ++m) { bf16_t* rowp = O + (size_t)(row0 + ai * HALF + m * 16) * D_ + col0;
#pragma unroll
                for (int bj = 0; bj < 2; ++bj) { const f32x4 v0 = acc[ai][bj][m][0], v1 = acc[ai][bj][m][1];
                    u32x4 w; w.x = cvt_pk_bf16(v0[0], v0[1]); w.y = cvt_pk_bf16(v0[2], v0[3]); w.z = cvt_pk_bf16(v1[0], v1[1]); w.w = cvt_pk_bf16(v1[2], v1[3]);
                    gst16(rowp + bj * HALF, w); } }
    }
};
__device__ __forceinline__ float silu_f(float x) { return x * __builtin_amdgcn_rcpf(1.f + __builtin_amdgcn_exp2f(-1.4426950408889634f * x)); }
__device__ __forceinline__ f32x4 silu_mul4(const f32x4 g, const f32x4 u) {
    constexpr float KA = -1.4426950408889634f * W8_INV, KC = 1.f / (W8_INV * W8_INV);
    const f32x4 arg = g * KA;
    const f32x4 e = (f32x4){__builtin_amdgcn_exp2f(arg[0]), __builtin_amdgcn_exp2f(arg[1]), __builtin_amdgcn_exp2f(arg[2]), __builtin_amdgcn_exp2f(arg[3])};
    const f32x4 d = e * KC + KC;
    const f32x4 r = (f32x4){__builtin_amdgcn_rcpf(d[0]), __builtin_amdgcn_rcpf(d[1]), __builtin_amdgcn_rcpf(d[2]), __builtin_amdgcn_rcpf(d[3])};
    return (g * u) * r;
}
struct EpiUp8 {
    static constexpr bool PERM = true, AFTER_DRAIN = false;
    unsigned char* H;
#ifdef PROBE_NOEPI_UP
    int skip;
#endif
    __device__ __forceinline__ void operator()(const f32x4 (&acc)[2][2][4][2], const Unit& u, int wr, int wc, int fr, int fq) const {
#ifdef PROBE_NOEPI_UP
        if (skip) return;
#endif
        const int row0 = u.pm * BM + wr * 64 + fr, col0 = (u.pn & 7) * HALF + wc * 32 + 8 * fq;
#pragma unroll
        for (int ai = 0; ai < 2; ++ai)
#pragma unroll
            for (int m = 0; m < 4; ++m) {
                const f32x4 o0 = silu_mul4(acc[ai][0][m][0], acc[ai][1][m][0]), o1 = silu_mul4(acc[ai][0][m][1], acc[ai][1][m][1]);
                unsigned w0 = pk4_fp8(o0[0], o0[1], o0[2], o0[3]);
                unsigned w1 = pk4_fp8(o1[0], o1[1], o1[2], o1[3]);
                typedef unsigned u32x2_t __attribute__((ext_vector_type(2)));
                gst8(H + (size_t)(row0 + ai * HALF + m * 16) * D_ + col0, (u32x2_t){w0, w1}); }
    }
};
struct EpiDown {
    static constexpr bool PERM = true, AFTER_DRAIN = false;
    unsigned char* Y; const PG8_LAS float* gl;
    __device__ __forceinline__ void operator()(const f32x4 (&acc)[2][2][4][2], const Unit& u, int wr, int wc, int fr, int fq) const {
        const int rt = wr * 64 + fr, row0 = u.pm * BM + rt, col0 = (u.pn & 3) * BM + wc * 32 + 8 * fq;
        typedef unsigned u32x2_t __attribute__((ext_vector_type(2)));
#pragma unroll
        for (int ai = 0; ai < 2; ++ai)
#pragma unroll
            for (int m = 0; m < 4; ++m) { const int row = row0 + ai * HALF + m * 16; const float g = gl[u.ui * 256 + rt + ai * HALF + m * 16]; unsigned char* rowp = Y + (size_t)row * D_ + col0;
#pragma unroll
                for (int bj = 0; bj < 2; ++bj) { const f32x4 v0 = acc[ai][bj][m][0] * g, v1 = acc[ai][bj][m][1] * g;
                    gst8(rowp + bj * HALF, (u32x2_t){pk4_fp8(v0[0], v0[1], v0[2], v0[3]), pk4_fp8(v1[0], v1[1], v1[2], v1[3])}); } }
    }
};
}

constexpr size_t WB_IN = 0, WB_OUT = 6 * MiB, WB_13 = 8 * MiB, WB_2 = 40 * MiB;
__device__ __forceinline__ unsigned cvtpk_w(float lo, float hi) { unsigned r; asm volatile("v_cvt_pk_bf16_f32 %0, %1, %2" : "=v"(r) : "v"(lo), "v"(hi)); return r; }
__device__ __forceinline__ void transpose_item(const float* W, int N, int srccol0, bf16* WT, int kb, LAS float* scr, int lane) {
    const int k0 = 64 * kb;
    float tmp[32];
    const float* src = W + (size_t)(k0 + (lane >> 5)) * N + (srccol0 < 0 ? 0 : srccol0) + (lane & 31);
#pragma unroll
    for (int i = 0; i < 32; ++i) tmp[i] = src[(size_t)(2 * i) * N];
#pragma unroll
    for (int i = 0; i < 32; ++i) scr[(2 * i + (lane >> 5)) * 33 + (lane & 31)] = (srccol0 < 0) ? 0.f : tmp[i];
    asm volatile("s_waitcnt lgkmcnt(0)" ::: "memory");
    const int c = lane & 7;
#pragma unroll
    for (int j = 0; j < 4; ++j) { const int n = (lane >> 3) + 8 * j; const LAS float* s = scr + (8 * c) * 33 + n;
        v4u o; o.x = cvtpk_w(s[0 * 33], s[1 * 33]); o.y = cvtpk_w(s[2 * 33], s[3 * 33]); o.z = cvtpk_w(s[4 * 33], s[5 * 33]); o.w = cvtpk_w(s[6 * 33], s[7 * 33]);
        *(v4u*)(WT + (size_t)n * D_ + k0 + 8 * c) = o; }
    asm volatile("s_waitcnt lgkmcnt(0)" ::: "memory");
}
__device__ __forceinline__ void transpose_item_fp8(const float* W, int N, int srccol0, unsigned char* WT8, int kb, LAS float* scr, int lane) {
    const int k0 = 64 * kb;
    float tmp[32];
    const float* src = W + (size_t)(k0 + (lane >> 5)) * N + srccol0 + (lane & 31);
#pragma unroll
    for (int i = 0; i < 32; ++i) tmp[i] = src[(size_t)(2 * i) * N];
#pragma unroll
    for (int i = 0; i < 32; ++i) scr[(2 * i + (lane >> 5)) * 33 + (lane & 31)] = tmp[i] * W8_SCALE;
    asm volatile("s_waitcnt lgkmcnt(0)" ::: "memory");
    const int n = lane >> 1, hf = lane & 1;
    const LAS float* sp = scr + (32 * hf) * 33 + n;
    v4u o0, o1;
    o0.x = pk4_fp8(sp[0 * 33], sp[1 * 33], sp[2 * 33], sp[3 * 33]);     o0.y = pk4_fp8(sp[4 * 33], sp[5 * 33], sp[6 * 33], sp[7 * 33]);
    o0.z = pk4_fp8(sp[8 * 33], sp[9 * 33], sp[10 * 33], sp[11 * 33]);   o0.w = pk4_fp8(sp[12 * 33], sp[13 * 33], sp[14 * 33], sp[15 * 33]);
    o1.x = pk4_fp8(sp[16 * 33], sp[17 * 33], sp[18 * 33], sp[19 * 33]); o1.y = pk4_fp8(sp[20 * 33], sp[21 * 33], sp[22 * 33], sp[23 * 33]);
    o1.z = pk4_fp8(sp[24 * 33], sp[25 * 33], sp[26 * 33], sp[27 * 33]); o1.w = pk4_fp8(sp[28 * 33], sp[29 * 33], sp[30 * 33], sp[31 * 33]);
    unsigned char* dst = WT8 + (size_t)n * D_ + k0 + 32 * hf;
    *(v4u*)dst = o0; *(v4u*)(dst + 16) = o1;
    asm volatile("s_waitcnt lgkmcnt(0)" ::: "memory");
}
constexpr int WP_NRB = 96 + 32 + 1024 + 512, WP_NIT = 16 * WP_NRB;
constexpr int WP_R0 = 3600, WP_R1 = 15600, WP_R2 = 19600;
__device__ __forceinline__ void p_wprep(const Ctx& a, LAS unsigned char* lds, int layer, int tid, int it_lo, int it_hi, int worker, int nworkers) {
    const int lane = tid & 63, wave = __builtin_amdgcn_readfirstlane(tid >> 6);
    LAS float* scr = (LAS float*)(lds + wave * 16384);
    const int gw = worker * NWAVES + wave, NGW = nworkers * NWAVES;
    unsigned char* wb = a.ws() + WS_WB + (size_t)layer * WB_LAYER;
    const float* w_in = a.in(8) + (size_t)layer * D_ * DIN; const float* w_out = a.in(20) + (size_t)layer * D_ * D_;
    const float* w1 = a.in(22) + (size_t)layer * NE * D_ * D_; const float* w3 = a.in(23) + (size_t)layer * NE * D_ * D_; const float* w2 = a.in(24) + (size_t)layer * NE * D_ * D_;
    constexpr int NRB = WP_NRB;
    for (int it = it_lo + gw; it < it_hi; it += NGW) {
        const int kb = it / NRB, rb = it % NRB;
        if (rb < 96) transpose_item(w_in, DIN, ref_col(32 * rb), (bf16*)(wb + WB_IN) + (size_t)(32 * rb) * D_, kb, scr, lane);
        else if (rb < 128) transpose_item(w_out, D_, 32 * (rb - 96), (bf16*)(wb + WB_OUT) + (size_t)(32 * (rb - 96)) * D_, kb, scr, lane);
        else if (rb < 1152) { const int q = rb - 128, e = q >> 6, w = q & 63, tile = w >> 3, within = w & 7;
            transpose_item_fp8((within < 4 ? w1 : w3) + (size_t)e * D_ * D_, D_, 128 * tile + 32 * (within & 3), wb + WB_13 + ((size_t)e * 2048 + 32 * w) * D_, kb, scr, lane); }
        else { const int q = rb - 1152, e = q >> 5, w = q & 31;
            transpose_item_fp8(w2 + (size_t)e * D_ * D_, D_, 32 * w, wb + WB_2 + ((size_t)e * 1024 + 32 * w) * D_, kb, scr, lane); }
    }
}
__device__ __forceinline__ void wprep_in_slack(const Ctx& a, LAS unsigned char* lds, int nunits, int lo, int hi) {
    const int G = gridDim.x, rem = nunits % 256;
    if (G != 256 || rem == 0 || (int)blockIdx.x < rem) return;
    __syncthreads();
    p_wprep(a, lds, 1, otid(), lo, hi, (int)blockIdx.x - rem, 256 - rem);
}
#ifndef SLACK_FIRST
#define SLACK_FIRST 0
#endif
#ifndef STAG_IN
#define STAG_IN 0
#endif
#ifndef STAG_OUT
#define STAG_OUT 0
#endif
#ifndef STAG_UP
#define STAG_UP 0
#endif
#ifndef STAG_DOWN
#define STAG_DOWN 0
#endif
#ifndef STAG_GROUPS
#define STAG_GROUPS 2
#endif
__device__ __forceinline__ void stagger_delay(int ticks) {
    const int g = ((int)blockIdx.x >> 3) % STAG_GROUPS;
    if (ticks <= 0 || g == 0) return;
    const unsigned long long t0 = __builtin_amdgcn_s_memrealtime(), dt = (unsigned long long)(g * ticks / STAG_GROUPS);
    while (__builtin_amdgcn_s_memrealtime() - t0 < dt) __builtin_amdgcn_s_sleep(8);
}
#ifndef PG8_SP2
#define PG8_SP2 true
#endif
#ifndef PG8_ALIGN
#define PG8_ALIGN true
#endif
__device__ __forceinline__ void p_gemm_in_fast(const Ctx& a, LAS unsigned char* lds, int layer, int skip = 0) {
    unsigned char* ws = a.ws();
    pg8::Gemm g{(const bf16*)(ws + WS_HN), (const bf16*)(ws + WS_WB + (size_t)layer * WB_LAYER + WB_IN), MT, NP, D_};
    pg8::DenseOrder2 S{(layer == 0) ? MT / 256 : NLAT / 256, NP / 256, (layer == 0) ? 0 : NCTX / 256, 4, NLAT / 256, (int)gridDim.x, (int)blockIdx.x};
#ifdef PROBE_NOSTORE
    pg8::EpiProj E{(bf16*)(ws + WS_PROJ), skip};
#else
    pg8::EpiProj E{(bf16*)(ws + WS_PROJ)};
#endif
    stagger_delay(STAG_IN);
#if SLACK_FIRST
    if (layer == 0) { wprep_in_slack(a, lds, (MT / 256) * (NP / 256), 0, WP_R0); __syncthreads(); }
#endif
    pg8::gemm_phase<pg8::EpiProj, pg8::DenseOrder2, PG8_ALIGN, PG8_SP2>(lds, g, S, E);
#if !SLACK_FIRST
    if (layer == 0) wprep_in_slack(a, lds, (MT / 256) * (NP / 256), 0, WP_R0);
#endif
}
__device__ __forceinline__ void p_gemm_out_fast(const Ctx& a, LAS unsigned char* lds, int layer) {
    unsigned char* ws = a.ws();
    pg8::Gemm g{(const bf16*)(ws + WS_YMIX), (const bf16*)(ws + WS_WB + (size_t)layer * WB_LAYER + WB_OUT), MT, D_, D_};
    pg8::DenseOrder2 S{(layer == 0) ? MT / 256 : NLAT / 256, D_ / 256, 0, 1, 0, (int)gridDim.x, (int)blockIdx.x};
    pg8::EpiY E{(bf16*)(ws + WS_YO)};
    stagger_delay(STAG_OUT);
#if SLACK_FIRST
    if (layer == 0) { wprep_in_slack(a, lds, (MT / 256) * (D_ / 256), WP_R0, WP_R1); __syncthreads(); }
#endif
    pg8::gemm_phase<pg8::EpiY, pg8::DenseOrder2, PG8_ALIGN, PG8_SP2>(lds, g, S, E);
#if !SLACK_FIRST
    if (layer == 0) wprep_in_slack(a, lds, (MT / 256) * (D_ / 256), WP_R0, WP_R1);
#endif
}
constexpr int RIDX_OFF = RING_BYTES + 1024;
__device__ __forceinline__ void p_gemm_up_fast(const Ctx& a, LAS unsigned char* lds, int layer, int skip = 0) {
    unsigned char* ws = a.ws();
    pg8::Gemm g{(const bf16*)(ws + WS_HN), (const bf16*)(ws + WS_WB + (size_t)layer * WB_LAYER + WB_13), MT, NE * 2048, D_ / 2};
    pg8::GatherOrder S; S.te = (layer == 0) ? 18 : 16; S.NT = 8; S.G = (int)gridDim.x; S.c = (int)blockIdx.x; S.ridx = (const LAS int*)(lds + RIDX_OFF);
    {
        const int* IDX = (const int*)(ws + WS_IDX); const int tid = otid();
        pg8::Unit u;
        int rv[12];
#pragma unroll
        for (int i = 0; i < 12; ++i) { const bool ok = S.next(i, u); rv[i] = (ok && tid < 256) ? IDX[u.pm * 256 + tid] : -1; }
#pragma unroll
        for (int i = 0; i < 12; ++i) if (rv[i] >= 0) ((LAS int*)(lds + RIDX_OFF))[i * 256 + tid] = rv[i];
        __syncthreads();
    }
#ifdef PROBE_NOEPI_UP
    pg8::EpiUp8 E{ws + WS_HID, skip};
#else
    pg8::EpiUp8 E{ws + WS_HID};
#endif
    stagger_delay(STAG_UP);
    pg8::gemm_phase<pg8::EpiUp8, pg8::GatherOrder, PG8_ALIGN, PG8_SP2, true>(lds, g, S, E);
}
__device__ __forceinline__ void p_gemm_down_fast(const Ctx& a, LAS unsigned char* lds, int layer) {
    unsigned char* ws = a.ws();
    pg8::Gemm g{(const bf16*)(ws + WS_HID), (const bf16*)(ws + WS_WB + (size_t)layer * WB_LAYER + WB_2), NE * SLOTS, NE * 1024, D_ / 2};
    pg8::GroupedOrder S{(layer == 0) ? 18 : 16, 4, (int)gridDim.x, (int)blockIdx.x};
    {
        const float* GATE = (const float*)(ws + WS_GATE); const int tid = otid();
        pg8::Unit u; float gv[12]; bool ok[12];
#pragma unroll
        for (int i = 0; i < 12; ++i) { ok[i] = S.next(i, u) && tid < 256; gv[i] = ok[i] ? GATE[u.pm * 256 + tid] : 0.f; }
#pragma unroll
        for (int i = 0; i < 12; ++i) if (ok[i]) ((LAS float*)(lds + RIDX_OFF))[i * 256 + tid] = gv[i] * (W8_INV * Y8_SCALE);
        __syncthreads();
    }
    pg8::EpiDown E{ws + WS_Y2, (const LAS float*)(lds + RIDX_OFF)};
    stagger_delay(STAG_DOWN);
#if SLACK_FIRST
    if (layer == 0) { wprep_in_slack(a, lds, 16 * 18 * 4, WP_R1, WP_R2); __syncthreads(); }
#endif
    pg8::gemm_phase<pg8::EpiDown, pg8::GroupedOrder, PG8_ALIGN, PG8_SP2, true>(lds, g, S, E);
#if !SLACK_FIRST
    if (layer == 0) wprep_in_slack(a, lds, 16 * 18 * 4, WP_R1, WP_R2);
#endif
}

__global__ void __launch_bounds__(NWAVES * 64, 2) mk_fwd(Args args) {
    extern __shared__ __attribute__((aligned(16))) unsigned char lds_raw[];
    LAS unsigned char* lds = (LAS unsigned char*)lds_raw;
    const int tid = threadIdx.x;
    for (int u = tid; u < (LDS_BYTES - LDSCTL_OFF) / 4; u += NWAVES * 64) ((LAS unsigned*)(lds + LDSCTL_OFF))[u] = 0u;
    __syncthreads();
    {
        LAS unsigned long long* tabw = (LAS unsigned long long*)(lds + LDSCTL_OFF + 64);
        if (tid < 26) tabw[tid] = (unsigned long long)args.in[tid];
        if (tid == 26) tabw[26] = (unsigned long long)args.out;
        if (tid == 27) tabw[27] = (unsigned long long)args.ws;
    }
    __syncthreads();
    Ctx ctx; ctx.tab = (const LAS unsigned long long*)(lds + LDSCTL_OFF + 64);
    XcdBarrier bar; bar.bar = (unsigned*)(args.ws + WS_CTL) + CW_BAR; bar.x = 0; bar.st = nullptr;
    if (N_LAUNCHES == 1) bar = xcd_barrier_post((unsigned*)(args.ws + WS_CTL) + CW_BAR, (volatile LAS unsigned*)(lds + MISC_OFF) + 8);
    const int lo = args.ph_lo, hi = args.ph_hi;
#define IN(k) (lo <= (k) && (k) < hi)
#if defined(REPP)
#define REPS(k) for (int rep_ = 0; rep_ < (((k) == REPP) ? NREP : 1); ++rep_)
#else
#define REPS(k)
#endif
#define SEAM(k) do { if (IN(k) && IN((k) + 1)) xcd_barrier(bar); } while (0)
    if (IN(0)) REPS(0) { __syncthreads(); p_mod(ctx, lds, otid()); __syncthreads(); p_wprep(ctx, lds, 0, otid(), 0, WP_NIT, (int)blockIdx.x, (int)gridDim.x); }
    SEAM(0);
    for (int l = 0; l < 2; ++l) {
        const int pb = 1 + 9 * l;
        if (IN(pb + 0)) REPS(pb + 0) { __syncthreads(); if (l == 0) p_norm1<0>(ctx, otid()); else p_norm1<1>(ctx, otid()); if (l == 1) { __syncthreads(); p_wprep(ctx, lds, 1, otid(), (gridDim.x == 256) ? WP_R2 : 0, WP_NIT, (int)blockIdx.x, (int)gridDim.x); } }
        SEAM(pb + 0);
        if (IN(pb + 1)) REPS(pb + 1) {
#if defined(PROBE_NOSTORE) && defined(REPP)
            __syncthreads(); p_gemm_in_fast(ctx, lds, l, (pb + 1 == REPP && rep_ == 0) ? 1 : 0);
#else
            __syncthreads(); p_gemm_in_fast(ctx, lds, l);
#endif
        }
        SEAM(pb + 1);
        if (IN(pb + 2)) REPS(pb + 2) { p_mix(ctx, lds, l, otid()); }
        SEAM(pb + 2);
        if (IN(pb + 3)) REPS(pb + 3) { p_glaout(ctx, l, otid()); }
        SEAM(pb + 3);
        if (IN(pb + 4)) REPS(pb + 4) {
            __syncthreads(); p_gemm_out_fast(ctx, lds, l);
        }
        SEAM(pb + 4);
        if (IN(pb + 5)) REPS(pb + 5) { __syncthreads(); if (l == 0) p_norm2<0>(ctx, lds, otid()); else p_norm2<1>(ctx, lds, otid()); }
        SEAM(pb + 5);
        if (IN(pb + 6)) REPS(pb + 6) { __syncthreads(); p_topk(ctx, lds, l, otid()); }
        SEAM(pb + 6);
        if (IN(pb + 7)) REPS(pb + 7) {
#if defined(PROBE_NOEPI_UP) && defined(REPP)
            __syncthreads(); p_gemm_up_fast(ctx, lds, l, (pb + 7 == REPP && rep_ == 0) ? 1 : 0);
#else
            __syncthreads(); p_gemm_up_fast(ctx, lds, l);
#endif
        }
        SEAM(pb + 7);
        if (IN(pb + 8)) REPS(pb + 8) {
            __syncthreads(); p_gemm_down_fast(ctx, lds, l);
        }
        SEAM(pb + 8);
    }
    if (IN(19)) { p_norm1<2>(ctx, otid()); }
#undef IN
#undef SEAM
}

extern "C" void kernel_launch(void* const* d_in, const int* in_sizes, int n_in, void* d_out, int out_size, void* d_ws, size_t ws_size, hipStream_t stream) {
    static int grid = 0;
    if (grid == 0) {
        if (n_in != 26 || in_sizes[0] != NLAT * D_ || out_size != NLAT * D_ || ws_size < WS_END) {
            fprintf(stderr, "kernel_launch: unexpected shapes: n_in %d in0 %d out %d ws %zu (need %zu); nothing launched\n", n_in, n_in > 0 ? in_sizes[0] : -1, out_size, ws_size, (size_t)WS_END);
            grid = -1; return;
        }
        int dev = 0, cus = 0, per_cu = 0;
        if (hipGetDevice(&dev) != hipSuccess || hipDeviceGetAttribute(&cus, hipDeviceAttributeMultiprocessorCount, dev) != hipSuccess) { grid = -1; return; }
        if (hipFuncSetAttribute((const void*)mk_fwd, hipFuncAttributeMaxDynamicSharedMemorySize, LDS_BYTES) != hipSuccess) { fprintf(stderr, "kernel_launch: hipFuncSetAttribute failed\n"); grid = -1; return; }
        if (hipOccupancyMaxActiveBlocksPerMultiprocessor(&per_cu, (const void*)mk_fwd, NWAVES * 64, LDS_BYTES) != hipSuccess || per_cu < 1) {
            fprintf(stderr, "kernel_launch: occupancy query reports %d blocks per CU; nothing launched\n", per_cu); (void)hipGetLastError(); grid = -1; return;
        }
        grid = cus;
    }
    if (grid < 0) return;
    if (hipMemsetAsync((char*)d_ws + WS_CTL, 0, CTL_ZERO_BYTES, stream) != hipSuccess) return;
    Args a{};
    for (int i = 0; i < 26; ++i) a.in[i] = (const float*)d_in[i];
    a.out = (float*)d_out; a.ws = (unsigned char*)d_ws;
    for (int li = 0; li < N_LAUNCHES; ++li) {
        if (N_LAUNCHES == 1) { a.ph_lo = 0; a.ph_hi = NPHASES; } else { a.ph_lo = li; a.ph_hi = li + 1; }
        a.li = li;
        hipLaunchKernelGGL(mk_fwd, dim3(grid), dim3(NWAVES * 64), LDS_BYTES, stream, a);
        const hipError_t le = hipPeekAtLastError();
        if (le != hipSuccess) { fprintf(stderr, "kernel_launch: launch %d failed: %s\n", li, hipGetErrorName(le)); break; }
    }
}
```

```cpp
#include <hip/hip_runtime.h>
#include <cstdio>
#include <cstdint>

#ifndef MK_N_LAUNCHES
#define MK_N_LAUNCHES 1
#endif

constexpr int NB_ = 16, L_ = 2048, LC_ = 256, D_ = 1024;
constexpr int NLAT = NB_ * L_, NCTX = NB_ * LC_, MT = NLAT + NCTX;
constexpr int DIN = 2848, NP = 3072, NE = 16;
constexpr int CAP_L = 256, CAP_C = 32, SLOTS = NB_ * CAP_L + NB_ * CAP_C;
constexpr float EPS = 1e-6f;
constexpr int PK = 0, PV = 256, PAF = 768, PAB = 784, PQ = 1024, PR = 1280, PCA = 1792, PCG = 2048, PSB = 2304, PSC = 2560, PSX = 2816;
constexpr int NPHASES = 20;
constexpr int N_LAUNCHES = MK_N_LAUNCHES;

constexpr size_t MiB = 1u << 20;
constexpr size_t WS_CTL = 0, CTL_ZERO_BYTES = 32768;
constexpr size_t WS_MOD = 1 * MiB;
constexpr size_t WS_AFF = 2 * MiB;
constexpr size_t WS_IDX = 5 * MiB;
constexpr size_t WS_GATE = 5 * MiB + 512 * 1024;
constexpr size_t WS_INV = 6 * MiB;
constexpr size_t WS_X16 = 9 * MiB;
constexpr size_t WS_WB = 25 * MiB, WB_LAYER = 56 * MiB;
constexpr size_t WS_HN = 137 * MiB;
constexpr size_t WS_PROJ = 209 * MiB;
constexpr size_t WS_OGLA = 425 * MiB;
constexpr size_t WS_YMIX = 497 * MiB;
constexpr size_t WS_Y2 = 209 * MiB;
constexpr size_t WS_HID = 353 * MiB;
constexpr size_t WS_YO = 425 * MiB;
constexpr size_t WS_XA16 = WS_YMIX;
constexpr size_t WS_END = 569 * MiB;
constexpr int CW_BAR = 4096;

constexpr int NWAVES = 8;
constexpr int RING_BYTES = 131072;
constexpr int LDSCTL_OFF = RING_BYTES, MISC_OFF = LDSCTL_OFF + 320;
constexpr int LDS_BYTES = 147456;

#define GAS __attribute__((address_space(1)))
#define LAS __attribute__((address_space(3)))
typedef unsigned short bf16;
typedef unsigned v4u __attribute__((ext_vector_type(4)));
typedef unsigned v2u __attribute__((ext_vector_type(2)));
typedef float f32x4 __attribute__((ext_vector_type(4)));
typedef float f32x16 __attribute__((ext_vector_type(16)));
typedef GAS unsigned gu32;

__device__ __forceinline__ float bf2f(unsigned h) { return __uint_as_float(h << 16); }
__device__ __forceinline__ unsigned f2bf(float f) { unsigned u = __float_as_uint(f); return (u + 0x7fffu + ((u >> 16) & 1u)) >> 16; }
typedef float f32x2p_t __attribute__((ext_vector_type(2))); typedef __bf16 bf16x2p_t __attribute__((ext_vector_type(2)));
__device__ __forceinline__ unsigned pk2(float lo, float hi) { f32x2p_t v = {lo, hi}; bf16x2p_t b = __builtin_convertvector(v, bf16x2p_t); return __builtin_bit_cast(unsigned, b); }
__device__ __forceinline__ f32x4 unpack4(v2u w) { return (f32x4){__uint_as_float(w.x << 16), __uint_as_float(w.x & 0xffff0000u), __uint_as_float(w.y << 16), __uint_as_float(w.y & 0xffff0000u)}; }
__device__ __forceinline__ v2u pack4(f32x4 v) { v2u r; r.x = pk2(v.x, v.y); r.y = pk2(v.z, v.w); return r; }
__device__ __forceinline__ float wave_sum(float v) {
#pragma unroll
    for (int o = 1; o < 64; o <<= 1) v += __shfl_xor(v, o);
    return v;
}
__device__ __forceinline__ int wave_sum_i(int v) {
#pragma unroll
    for (int o = 1; o < 64; o <<= 1) v += __shfl_xor(v, o);
    return v;
}
__device__ __forceinline__ float sigm(float x) { return __builtin_amdgcn_rcpf(1.f + __builtin_amdgcn_exp2f(-1.4426950408889634f * x)); }
__device__ __forceinline__ float silu(float x) { return x * __builtin_amdgcn_rcpf(1.f + __builtin_amdgcn_exp2f(-1.4426950408889634f * x)); }

__device__ __forceinline__ void rst_pair16(bf16* slot_r0, bf16* slot_r1, v2u pa, v2u pb, bool odd) {
    const unsigned sx = odd ? pa.x : pb.x, sy = odd ? pa.y : pb.y;
    const unsigned rx = (unsigned)__shfl_xor((int)sx, 1), ry = (unsigned)__shfl_xor((int)sy, 1);
    v4u out; out.x = odd ? rx : pa.x; out.y = odd ? ry : pa.y; out.z = odd ? pb.x : rx; out.w = odd ? pb.y : ry;
    *(v4u*)(odd ? slot_r1 - 4 : slot_r0) = out;
}
__device__ __forceinline__ void rst_pair8(unsigned char* slot_r0, unsigned char* slot_r1, unsigned pa, unsigned pb, bool odd) {
    const unsigned sx = odd ? pa : pb;
    const unsigned rx = (unsigned)__shfl_xor((int)sx, 1);
    v2u out; out.x = odd ? rx : pa; out.y = odd ? pb : rx;
    *(v2u*)(odd ? slot_r1 - 4 : slot_r0) = out;
}
#define XB_TMO      128
#define XB_XCNT(j)  (256  + 64 * (j))
#define XB_XSUB(j)  (1280 + 64 * (j))
#define XB_XGEN(j)  (2304 + 64 * (j))
#define XB_TOP      3328
#define XB_TOPGEN   3392
#define XCD_BAR_WORDS 3456
#define XB_SPIN_CAP (1u << 18)
__device__ __forceinline__ unsigned xb_ld(unsigned* p)              { return __hip_atomic_load(p, __ATOMIC_RELAXED, __HIP_MEMORY_SCOPE_AGENT); }
__device__ __forceinline__ unsigned xb_add(unsigned* p, unsigned v) { return __hip_atomic_fetch_add(p, v, __ATOMIC_RELAXED, __HIP_MEMORY_SCOPE_AGENT); }
__device__ __forceinline__ unsigned xb_xcc_id() { return (unsigned)__builtin_amdgcn_s_getreg((3 << 11) | 20) & 0xFu; }
#define XB_SPIN(cond, bar) do { unsigned _sp = 0; while (cond) { __builtin_amdgcn_s_sleep(1); \
    if ((++_sp & 255u) == 0u) { if (xb_ld(&(bar)[XB_TMO])) break; if (_sp > XB_SPIN_CAP) { atomicAdd(&(bar)[XB_TMO], 1u); break; } } } } while (0)
struct XcdBarrier { unsigned* bar; unsigned x; volatile LAS unsigned* st; };
__device__ __forceinline__ XcdBarrier xcd_barrier_post(unsigned* bar, volatile LAS unsigned* st) {
    XcdBarrier b; b.bar = bar; b.x = xb_xcc_id(); b.st = st;
    if (threadIdx.x == 0) (void)xb_add(&bar[XB_XCNT(b.x)], 1u);
    return b;
}
__device__ __forceinline__ void xcd_barrier_complete(unsigned* bar, unsigned x, unsigned& nloc, unsigned& nx) {
    const unsigned G = gridDim.x * gridDim.y * gridDim.z;
    unsigned sum, cnt, mine, sp = 0u;
    for (;;) {
        sum = 0u; cnt = 0u; mine = 0u;
#pragma unroll
        for (unsigned j = 0; j < 16; ++j) { const unsigned c = xb_ld(&bar[XB_XCNT(j)]); sum += c; cnt += (c > 0u) ? 1u : 0u; mine = (j == x) ? c : mine; }
        if (sum == G) break;
        __builtin_amdgcn_s_sleep(1);
        if ((++sp & 255u) == 0u) { if (xb_ld(&bar[XB_TMO])) break; if (sp > XB_SPIN_CAP) { atomicAdd(&bar[XB_TMO], 1u); break; } }
    }
    nloc = mine > 0u ? mine : 1u; nx = cnt > 0u ? cnt : 1u;
}
__device__ __forceinline__ void xcd_barrier_census_wave(unsigned* bar, unsigned x, volatile LAS unsigned* st) {
    const unsigned G = gridDim.x * gridDim.y * gridDim.z, lane = threadIdx.x;
    unsigned c, sum, sp = 0u;
    for (;;) {
        c = (lane < 16u) ? xb_ld(&bar[XB_XCNT(lane)]) : 0u;
        sum = c;
#pragma unroll
        for (int o = 1; o < 16; o <<= 1) sum += (unsigned)__shfl_xor((int)sum, o);
        sum = (unsigned)__builtin_amdgcn_readfirstlane((int)sum);
        if (sum == G) break;
        __builtin_amdgcn_s_sleep(1);
        if ((++sp & 255u) == 0u) { if (__builtin_amdgcn_readfirstlane((int)xb_ld(&bar[XB_TMO]))) break; if (sp > XB_SPIN_CAP) { if (lane == 0u) atomicAdd(&bar[XB_TMO], 1u); break; } }
    }
    const unsigned cnt = (unsigned)__builtin_popcountll(__ballot(c > 0u));
    const unsigned mine = (unsigned)__builtin_amdgcn_readlane((int)c, (int)x);
    if (lane == 0u) { st[0] = mine > 0u ? mine : 1u; st[1] = cnt > 0u ? cnt : 1u; }
}
__device__ __forceinline__ void xcd_barrier(const XcdBarrier& b) {
    asm volatile("s_waitcnt vmcnt(0)" ::: "memory");
    __syncthreads();
    if (threadIdx.x < 64u && b.st[0] == 0u) xcd_barrier_census_wave(b.bar, b.x, b.st);
    if (threadIdx.x == 0) {
        unsigned* bar = b.bar;
        __builtin_amdgcn_s_waitcnt(0);
        unsigned nloc = b.st[0], nx = b.st[1];
        if (nloc == 0u) { xcd_barrier_complete(bar, b.x, nloc, nx); b.st[0] = nloc; b.st[1] = nx; }
        const unsigned old = xb_add(&bar[XB_XSUB(b.x)], 1u);
        const unsigned gen = old / nloc;
        if (old + 1u == (gen + 1u) * nloc) {
            __builtin_amdgcn_fence(__ATOMIC_RELEASE, "agent");
            asm volatile("s_waitcnt vmcnt(0)" ::: "memory");
            const unsigned og = xb_add(&bar[XB_TOP], 1u);
            const unsigned tg = og / nx;
            if (og + 1u == (tg + 1u) * nx) xb_add(&bar[XB_TOPGEN], 1u);
            else XB_SPIN(xb_ld(&bar[XB_TOPGEN]) == tg, bar);
            __builtin_amdgcn_fence(__ATOMIC_ACQUIRE, "agent");
            xb_add(&bar[XB_XGEN(b.x)], 1u);
            asm volatile("s_waitcnt vmcnt(0)" ::: "memory");
        } else {
            XB_SPIN(xb_ld(&bar[XB_XGEN(b.x)]) == gen, bar);
            __builtin_amdgcn_fence(__ATOMIC_ACQUIRE, "agent");
            asm volatile("s_waitcnt vmcnt(0)" ::: "memory");
        }
    }
    __syncthreads();
}

__device__ __forceinline__ unsigned pk4_fp8(float a, float b, float c, float d) {
    a = __builtin_amdgcn_fmed3f(a, -448.f, 448.f); b = __builtin_amdgcn_fmed3f(b, -448.f, 448.f); c = __builtin_amdgcn_fmed3f(c, -448.f, 448.f); d = __builtin_amdgcn_fmed3f(d, -448.f, 448.f);
    unsigned w = 0u;
    w = (unsigned)__builtin_amdgcn_cvt_pk_fp8_f32(a, b, (int)w, false);
    w = (unsigned)__builtin_amdgcn_cvt_pk_fp8_f32(c, d, (int)w, true);
    return w;
}
constexpr float W8_SCALE = 32.f, W8_INV = 1.f / 32.f;
constexpr float Y8_SCALE = 64.f, Y8_INV = 1.f / 64.f;
typedef float f32x2u_t __attribute__((ext_vector_type(2)));
__device__ __forceinline__ f32x4 unpack4_fp8(unsigned w) { const f32x2u_t a = __builtin_amdgcn_cvt_pk_f32_fp8((int)w, false), b = __builtin_amdgcn_cvt_pk_f32_fp8((int)w, true); return (f32x4){a.x, a.y, b.x, b.y}; }
__device__ __forceinline__ int otid() { int t = threadIdx.x; asm volatile("" : "+v"(t)); return t; }
struct Args { const float* in[26]; float* out; unsigned char* ws; int ph_lo, ph_hi, li, pad; };
struct Ctx {
    const LAS unsigned long long* tab;
    __device__ __forceinline__ unsigned long long get(int k) const {
        const unsigned long long v = tab[k];
        const unsigned lo = __builtin_amdgcn_readfirstlane((unsigned)v), hi = __builtin_amdgcn_readfirstlane((unsigned)(v >> 32));
        return ((unsigned long long)hi << 32) | lo;
    }
    __device__ __forceinline__ const float* in(int k) const { return (const float*)(const GAS float*)get(k); }
    __device__ __forceinline__ float* out() const { return (float*)(GAS float*)get(26); }
    __device__ __forceinline__ unsigned char* ws() const { return (unsigned char*)(GAS unsigned char*)get(27); }
};

__device__ __forceinline__ int ref_col(int c) {
    if (c < 256) return 768 + c;
    if (c < 768) return 1024 + (c - 256);
    if (c < 800) return 1536 + (c - 768);
    if (c < 1024) return -1;
    if (c < 1280) return 512 + (c - 1024);
    if (c < 1792) return 1568 + (c - 1280);
    if (c < 2304) return c - 1792;
    return 2080 + (c - 2304);
}

__device__ __forceinline__ void p_mod(const Ctx& a, LAS unsigned char* lds, int tid) {
    const int lane = tid & 63, wave = tid >> 6;
    LAS float* s = (LAS float*)lds;
    LAS float* red = (LAS float*)(lds + 69632);
    const float* c = a.in(1); const float* cc = a.in(3);
    float* MODp = (float*)(a.ws() + WS_MOD);
    const float* adaw = a.in(4); const float* adab = a.in(5);
    if ((int)blockIdx.x < 192) {
        float cv[34];
#pragma unroll
        for (int k = 0; k < 34; ++k) { const int i = tid + 512 * k; cv[k] = (i < 16 * 1024) ? c[i] : cc[i - 16 * 1024]; }
#pragma unroll
        for (int k = 0; k < 34; ++k) { const float v = cv[k]; s[tid + 512 * k] = v / (1.f + expf(-v)); }
    }
    __syncthreads();
    for (int task = blockIdx.x; task < 192; task += gridDim.x) {
        const int l = task / 96, n0 = (task % 96) * 64;
        const float* W = adaw + (size_t)l * 1024 * 6144 + n0 + lane;
        float acc[17];
#pragma unroll
        for (int j = 0; j < 17; ++j) acc[j] = 0.f;
        const int k0 = wave * 128;
        float wn[8], wn2[8];
#pragma unroll
        for (int u = 0; u < 8; ++u) { wn[u] = W[(size_t)(k0 + u) * 6144]; wn2[u] = W[(size_t)(k0 + 8 + u) * 6144]; }
#pragma unroll 1
        for (int k = k0; k < k0 + 128; k += 8) {
            float w[8];
#pragma unroll
            for (int u = 0; u < 8; ++u) { w[u] = wn[u]; wn[u] = wn2[u]; }
            if (k + 16 < k0 + 128) {
#pragma unroll
                for (int u = 0; u < 8; ++u) wn2[u] = W[(size_t)(k + 16 + u) * 6144];
            }
            __builtin_amdgcn_sched_barrier(0);
            const LAS float* sp = s + k;
#pragma unroll
            for (int u4 = 0; u4 < 2; ++u4) {
                asm volatile("" : "+v"(sp) : "v"(acc[16]));
#pragma unroll
                for (int j = 0; j < 17; ++j) { const f32x4 sv = *(const LAS f32x4*)(sp + j * 1024 + 4 * u4); acc[j] += sv.x * w[4 * u4] + sv.y * w[4 * u4 + 1] + sv.z * w[4 * u4 + 2] + sv.w * w[4 * u4 + 3]; }
            }
        }
#pragma unroll
        for (int j = 0; j < 17; ++j) red[(wave * 17 + j) * 64 + lane] = acc[j];
        __syncthreads();
        for (int i = tid; i < 17 * 64; i += 512) {
            const int j = i >> 6, n = i & 63; float t = 0.f;
#pragma unroll
            for (int w = 0; w < 8; ++w) t += red[(w * 17 + j) * 64 + n];
            MODp[(size_t)(l * 17 + j) * 6144 + n0 + n] = t + adab[l * 6144 + n0 + n];
        }
        __syncthreads();
    }
}

template <int M> struct RawX { typedef v2u t; };
template <> struct RawX<0> { typedef f32x4 t; };
template <int MODE> __device__ __forceinline__ void p_norm1(const Ctx& a, int tid) {
    typedef typename RawX<MODE>::t rawx_t;
    const int lane = tid & 63, wave = tid >> 6;
    const int gw = blockIdx.x * NWAVES + wave, NGW = gridDim.x * NWAVES;
    constexpr int npairs = ((MODE == 2) ? NLAT : MT) / 2;
    constexpr int lp = (MODE == 1) ? 0 : 1;
    const float* MODp = (const float*)(a.ws() + WS_MOD);
    const int* INV = (const int*)(a.ws() + WS_INV);
    const unsigned char* Y2 = a.ws() + WS_Y2;
    bf16* HN = (bf16*)(a.ws() + WS_HN);
    const bf16* YOp = (const bf16*)(a.ws() + WS_YO);
    const float* xin = a.in(0); const float* cin = a.in(2); bf16* X16 = (bf16*)(a.ws() + WS_X16); float* OUTp = a.out();
    const bf16* XA16 = (const bf16*)(a.ws() + WS_XA16);
    const float* fwp = a.in(25); const float* n1w = a.in(6);
    rawx_t nx[8]; v2u ny[8]; unsigned ng[2][4][4];
    int inv_c0 = -1, inv_c1 = -1, inv_n0 = -1, inv_n1 = -1;
    auto ldinv = [&](int pr, int& i0, int& i1) { const int row = 2 * pr; i0 = -1; i1 = -1;
        if (lane < 16) { const v2u t = *(const v2u*)(INV + (size_t)lane * MT + row); i0 = (int)t.x; i1 = (int)t.y; } };
    auto issue_rows = [&](int pr) {
        const int row = 2 * pr;
        if (MODE == 0) { const float* src = ((row >= NLAT) ? cin + (size_t)(row - NLAT) * D_ : xin + (size_t)row * D_) + 4 * lane;
#pragma unroll
            for (int q = 0; q < 4; ++q) { *(f32x4*)&nx[q] = *(const f32x4*)(src + 256 * q); *(f32x4*)&nx[4 + q] = *(const f32x4*)(src + D_ + 256 * q); } }
        else { const bf16* src = ((MODE == 1) ? XA16 : (const bf16*)X16) + (size_t)row * D_ + 4 * lane;
#pragma unroll
            for (int q = 0; q < 4; ++q) { *(v2u*)&nx[q] = *(const v2u*)(src + 256 * q); *(v2u*)&nx[4 + q] = *(const v2u*)(src + D_ + 256 * q); } }
        if (MODE == 2) { const bf16* yo = YOp + (size_t)row * D_ + 4 * lane;
#pragma unroll
            for (int q = 0; q < 4; ++q) { ny[q] = *(const v2u*)(yo + 256 * q); ny[4 + q] = *(const v2u*)(yo + D_ + 256 * q); } }
    };
    auto issue_gather = [&](int inv, unsigned (&g)[4][4]) {
        unsigned mask = (unsigned)(__ballot(inv >= 0) & 0xffffull);
#pragma unroll
        for (int k = 0; k < 4; ++k) {
            const bool have = mask != 0u;
            const int e = have ? (int)__builtin_ctz(mask) : 0;
            const int slot = have ? __builtin_amdgcn_readlane(inv, e) : 0;
            const unsigned char* yp = Y2 + ((size_t)e * SLOTS + slot) * D_ + 4 * lane;
#pragma unroll
            for (int q = 0; q < 4; ++q) g[k][q] = *(const unsigned*)(yp + 256 * q);
            mask &= mask - 1u;
        }
    };
    auto combine = [&](f32x4 (&v)[4], int inv, const unsigned (&g)[4][4], const v2u* yo, const f32x4 (&m2q)[4], const f32x4 (&m5q)[4]) {
        f32x4 sum[4];
#pragma unroll
        for (int q = 0; q < 4; ++q) sum[q] = (f32x4){0.f, 0.f, 0.f, 0.f};
        unsigned mask = (unsigned)(__ballot(inv >= 0) & 0xffffull);
        const int cnt = __builtin_popcount(mask);
#pragma unroll
        for (int k = 0; k < 4; ++k) { const float w = (k < cnt) ? Y8_INV : 0.f;
#pragma unroll
            for (int q = 0; q < 4; ++q) sum[q] += unpack4_fp8(g[k][q]) * w;
            mask &= mask - 1u; }
        while (mask != 0u) {
            const unsigned char* yp[4]; float wgt[4];
#pragma unroll
            for (int k = 0; k < 4; ++k) {
                const bool have = mask != 0u;
                const int e = have ? (int)__builtin_ctz(mask) : 0;
                const int slot = have ? __builtin_amdgcn_readlane(inv, e) : 0;
                yp[k] = Y2 + ((size_t)e * SLOTS + slot) * D_ + 4 * lane; wgt[k] = have ? Y8_INV : 0.f;
                mask &= mask - 1u;
            }
            unsigned ld[4][4];
#pragma unroll
            for (int k = 0; k < 4; ++k)
#pragma unroll
                for (int q = 0; q < 4; ++q) ld[k][q] = *(const unsigned*)(yp[k] + 256 * q);
#pragma unroll
            for (int k = 0; k < 4; ++k)
#pragma unroll
                for (int q = 0; q < 4; ++q) sum[q] += unpack4_fp8(ld[k][q]) * wgt[k];
        }
#pragma unroll
        for (int q = 0; q < 4; ++q) {
            if (MODE == 2) v[q] += m2q[q] * unpack4(yo[q]);
            v[q] += m5q[q] * sum[q];
        }
    };
    if (MODE != 0) { if (gw < npairs) ldinv(gw, inv_c0, inv_c1); if (gw + NGW < npairs) ldinv(gw + NGW, inv_n0, inv_n1); }
    if (gw < npairs) { issue_rows(gw); if (MODE != 0) { issue_gather(inv_c0, ng[0]); issue_gather(inv_c1, ng[1]); } }
    for (int pr = gw; pr < npairs; pr += NGW) {
        const int row = 2 * pr;
        const bool isctx = row >= NLAT;
        const int j = isctx ? 16 : (row >> 11);
        f32x4 m2q[4], m5q[4], aq[4], bq[4], cq[4];
        if (MODE != 0) { const float* m5 = MODp + (size_t)(lp * 17 + j) * 6144 + 5120 + 4 * lane; const float* m2 = MODp + (size_t)(lp * 17 + j) * 6144 + 2048 + 4 * lane;
#pragma unroll
            for (int q = 0; q < 4; ++q) { m5q[q] = *(const f32x4*)(m5 + 256 * q); if (MODE == 2) m2q[q] = *(const f32x4*)(m2 + 256 * q); } }
        if (MODE == 2) {
#pragma unroll
            for (int q = 0; q < 4; ++q) aq[q] = *(const f32x4*)(fwp + 4 * lane + 256 * q);
        } else {
            constexpr int l = (MODE == 0) ? 0 : 1;
            const float* nw = n1w + l * D_ + 4 * lane; const float* sh = MODp + (size_t)(l * 17 + j) * 6144 + 4 * lane; const float* sc = sh + 1024;
#pragma unroll
            for (int q = 0; q < 4; ++q) { aq[q] = *(const f32x4*)(nw + 256 * q); bq[q] = *(const f32x4*)(sc + 256 * q); cq[q] = *(const f32x4*)(sh + 256 * q); }
        }
        f32x4 v0[4], v1[4]; v2u cy[8]; unsigned cg[2][4][4];
        const int ci0 = inv_c0, ci1 = inv_c1;
#pragma unroll
        for (int q = 0; q < 4; ++q) {
            if (MODE == 0) { v0[q] = *(const f32x4*)&nx[q]; v1[q] = *(const f32x4*)&nx[4 + q]; } else { v0[q] = unpack4(*(const v2u*)&nx[q]); v1[q] = unpack4(*(const v2u*)&nx[4 + q]); }
        }
        if (MODE == 2) {
#pragma unroll
            for (int q = 0; q < 8; ++q) cy[q] = ny[q];
        }
        if (MODE != 0) {
#pragma unroll
            for (int r = 0; r < 2; ++r)
#pragma unroll
                for (int k = 0; k < 4; ++k)
#pragma unroll
                    for (int q = 0; q < 4; ++q) cg[r][k][q] = ng[r][k][q];
        }
        if (MODE != 0) { inv_c0 = inv_n0; inv_c1 = inv_n1; if (pr + 2 * NGW < npairs) ldinv(pr + 2 * NGW, inv_n0, inv_n1); }
        if (pr + NGW < npairs) { issue_rows(pr + NGW); if (MODE != 0) { issue_gather(inv_c0, ng[0]); issue_gather(inv_c1, ng[1]); } }
        __builtin_amdgcn_sched_barrier(0);
        if (MODE != 0) {
            combine(v0, ci0, cg[0], cy, m2q, m5q);
            combine(v1, ci1, cg[1], cy + 4, m2q, m5q);
            if (MODE == 1 && !isctx) {
                bf16* x16 = X16 + (size_t)row * D_ + 4 * lane;
#pragma unroll
                for (int q = 0; q < 4; ++q) rst_pair16(x16 + 256 * q, x16 + D_ + 256 * q, pack4(v0[q]), pack4(v1[q]), lane & 1);
            }
        }
        float ss0 = 0.f, ss1 = 0.f;
#pragma unroll
        for (int q = 0; q < 4; ++q) {
            ss0 += (v0[q].x * v0[q].x + v0[q].y * v0[q].y) + (v0[q].z * v0[q].z + v0[q].w * v0[q].w);
            ss1 += (v1[q].x * v1[q].x + v1[q].y * v1[q].y) + (v1[q].z * v1[q].z + v1[q].w * v1[q].w);
        }
        ss0 = wave_sum(ss0); ss1 = wave_sum(ss1);
        const float rstd0 = rsqrtf(ss0 * (1.f / D_) + EPS), rstd1 = rsqrtf(ss1 * (1.f / D_) + EPS);
        if (MODE == 2) {
            float* dst = OUTp + (size_t)row * D_ + 4 * lane;
#pragma unroll
            for (int q = 0; q < 4; ++q) { *(f32x4*)(dst + 256 * q) = v0[q] * rstd0 * aq[q]; *(f32x4*)(dst + D_ + 256 * q) = v1[q] * rstd1 * aq[q]; }
        } else {
#pragma unroll
            for (int q = 0; q < 4; ++q) {
                const f32x4 g = aq[q] * (bq[q] + 1.f), bsh = cq[q];
                rst_pair16(HN + (size_t)row * D_ + 4 * lane + 256 * q, HN + (size_t)(row + 1) * D_ + 4 * lane + 256 * q, pack4(v0[q] * rstd0 * g + bsh), pack4(v1[q] * rstd1 * g + bsh), lane & 1);
            }
        }
    }
}

__device__ __forceinline__ float reduce16(const float (&t)[16], int lane) {
    const bool b5 = lane & 32, b4 = lane & 16, b3 = lane & 8, b2 = lane & 4;
    float u[8], w[4], x[2];
#pragma unroll
    for (int e = 0; e < 8; ++e) { const float keep = b5 ? t[e + 8] : t[e], send = b5 ? t[e] : t[e + 8]; u[e] = keep + __shfl_xor(send, 32); }
#pragma unroll
    for (int e = 0; e < 4; ++e) { const float keep = b4 ? u[e + 4] : u[e], send = b4 ? u[e] : u[e + 4]; w[e] = keep + __shfl_xor(send, 16); }
#pragma unroll
    for (int e = 0; e < 2; ++e) { const float keep = b3 ? w[e + 2] : w[e], send = b3 ? w[e] : w[e + 2]; x[e] = keep + __shfl_xor(send, 8); }
    const float keep = b2 ? x[1] : x[0], send = b2 ? x[0] : x[1];
    float y = keep + __shfl_xor(send, 4);
    y += __shfl_xor(y, 2); y += __shfl_xor(y, 1);
    return y;
}
template <int LAYER> __device__ __forceinline__ void p_norm2(const Ctx& a, LAS unsigned char* lds, int tid) {
    constexpr int layer = LAYER;
    const int lane = tid & 63, wave = tid >> 6;
    const int gw = blockIdx.x * NWAVES + wave, NGW = gridDim.x * NWAVES;
    const int npairs = ((layer == 0) ? MT : NLAT) / 2;
    const float* MODp = (const float*)(a.ws() + WS_MOD);
    unsigned char* HN8 = a.ws() + WS_HN;
    const bf16* YO = (const bf16*)(a.ws() + WS_YO);
    float* AFF = (float*)(a.ws() + WS_AFF);
    LAS float* rwT = (LAS float*)lds;
    const float* rw = a.in(21) + (size_t)layer * D_ * NE;
    const bf16* X16 = (const bf16*)(a.ws() + WS_X16); bf16* XA16 = (bf16*)(a.ws() + WS_XA16); const float* n2w = a.in(7);
    const float* xin = a.in(0); const float* cin = a.in(2);
    typedef f32x4 rawx_t;
    rawx_t nx[8]; v2u ny[8];
    auto xptr = [&](int pr) -> const unsigned char* { const int row = 2 * pr;
        if (layer == 0) return (const unsigned char*)(((row >= NLAT) ? cin + (size_t)(row - NLAT) * D_ : xin + (size_t)row * D_) + 4 * lane);
        return (const unsigned char*)(X16 + (size_t)row * D_ + 4 * lane); };
    auto ldx = [&](const unsigned char* p, int q, int r) -> rawx_t {
        if (layer == 0) return *(const f32x4*)(p + (size_t)r * D_ * 4 + 1024 * q);
        const v2u t = *(const v2u*)(p + (size_t)r * D_ * 2 + 512 * q); return (rawx_t){__uint_as_float(t.x), __uint_as_float(t.y), 0.f, 0.f}; };
    auto cvx = [&](const rawx_t& t) -> f32x4 { if (layer == 0) return t; return unpack4((v2u){__float_as_uint(t.x), __float_as_uint(t.y)}); };
    auto m2ptr = [&](int pr) -> const float* { const int row = 2 * pr; const int jj = (row >= NLAT) ? 16 : (row >> 11); return MODp + (size_t)(layer * 17 + jj) * 6144 + 2048 + 4 * lane; };
    if (gw < npairs) {
        const unsigned char* p = xptr(gw); const bf16* yp = YO + (size_t)(2 * gw) * D_ + 4 * lane;
#pragma unroll
        for (int q = 0; q < 4; ++q) { nx[q] = ldx(p, q, 0); nx[4 + q] = ldx(p, q, 1); ny[q] = *(const v2u*)(yp + 256 * q); ny[4 + q] = *(const v2u*)(yp + D_ + 256 * q); }
    }
    {
        f32x4 rv[8];
#pragma unroll
        for (int k = 0; k < 8; ++k) rv[k] = *(const f32x4*)(rw + 4 * (tid + 512 * k));
#pragma unroll
        for (int k = 0; k < 8; ++k) { const int kk = (tid + 512 * k) >> 2, e0 = 4 * (tid & 3);
            rwT[(e0 + 0) * 1024 + kk] = rv[k].x; rwT[(e0 + 1) * 1024 + kk] = rv[k].y; rwT[(e0 + 2) * 1024 + kk] = rv[k].z; rwT[(e0 + 3) * 1024 + kk] = rv[k].w; }
    }
    __syncthreads();
    for (int pr = gw; pr < npairs; pr += NGW) {
        const int row = 2 * pr;
        const bool isctx = row >= NLAT;
        const int j = isctx ? 16 : (row >> 11);
        const bool more = pr + NGW < npairs;
        const unsigned char* pn = xptr(more ? pr + NGW : pr); const bf16* ypn = YO + (size_t)(2 * (more ? pr + NGW : pr)) * D_ + 4 * lane;
        const float* m2 = m2ptr(pr);
        const float* sh = MODp + (size_t)(layer * 17 + j) * 6144 + 3072 + 4 * lane;
        const float* sc = sh + 1024;
        f32x4 scq[4], shq[4], nwq[4], nm2[4];
#pragma unroll
        for (int q = 0; q < 4; ++q) nm2[q] = *(const f32x4*)(m2 + 256 * q);
#pragma unroll
        for (int q = 0; q < 4; ++q) { scq[q] = *(const f32x4*)(sc + 256 * q); shq[q] = *(const f32x4*)(sh + 256 * q); nwq[q] = *(const f32x4*)(n2w + layer * D_ + 4 * lane + 256 * q); }
        __builtin_amdgcn_sched_barrier(0);
        f32x4 v0[4], v1[4];
        float ss0 = 0.f, ss1 = 0.f;
#pragma unroll
        for (int q = 0; q < 4; ++q) {
            const f32x4 g2 = nm2[q];
            v0[q] = cvx(nx[q]) + g2 * unpack4(ny[q]);
            v1[q] = cvx(nx[4 + q]) + g2 * unpack4(ny[4 + q]);
            ss0 += (v0[q].x * v0[q].x + v0[q].y * v0[q].y) + (v0[q].z * v0[q].z + v0[q].w * v0[q].w);
            ss1 += (v1[q].x * v1[q].x + v1[q].y * v1[q].y) + (v1[q].z * v1[q].z + v1[q].w * v1[q].w);
        }
        if (layer == 0) {
            bf16* xa = XA16 + (size_t)row * D_ + 4 * lane;
#pragma unroll
            for (int q = 0; q < 4; ++q) { *(v2u*)(xa + 256 * q) = pack4(v0[q]); *(v2u*)(xa + D_ + 256 * q) = pack4(v1[q]); }
        }
        ss0 = wave_sum(ss0); ss1 = wave_sum(ss1);
        const float rstd0 = rsqrtf(ss0 * (1.f / D_) + EPS), rstd1 = rsqrtf(ss1 * (1.f / D_) + EPS);
#pragma unroll
        for (int q = 0; q < 4; ++q) {
            const f32x4 g = nwq[q] * (scq[q] + 1.f), bsh = shq[q];
            v0[q] = v0[q] * rstd0 * g + bsh; v1[q] = v1[q] * rstd1 * g + bsh;
            *(unsigned*)(HN8 + (size_t)row * D_ + 4 * lane + 256 * q) = pk4_fp8(v0[q].x, v0[q].y, v0[q].z, v0[q].w);
            *(unsigned*)(HN8 + (size_t)(row + 1) * D_ + 4 * lane + 256 * q) = pk4_fp8(v1[q].x, v1[q].y, v1[q].z, v1[q].w);
        }
        __builtin_amdgcn_sched_barrier(0);
        if (more) {
#pragma unroll
            for (int q = 0; q < 4; ++q) { nx[q] = ldx(pn, q, 0); nx[4 + q] = ldx(pn, q, 1); ny[q] = *(const v2u*)(ypn + 256 * q); ny[4 + q] = *(const v2u*)(ypn + D_ + 256 * q); }
        }
        __builtin_amdgcn_sched_barrier(0);
        float t0[16], t1[16];
#pragma unroll
        for (int e = 0; e < 16; ++e) { t0[e] = 0.f; t1[e] = 0.f; }
        const LAS float* rwq = rwT + 4 * lane;
#pragma unroll
        for (int q = 0; q < 4; ++q) {
            const f32x4 h0 = v0[q], h1 = v1[q];
#pragma unroll
            for (int eh = 0; eh < 16; eh += 8) {
                asm volatile("" : "+v"(rwq) : "v"(t0[(eh + 15) & 15]), "v"(t1[(eh + 15) & 15]));
#pragma unroll
                for (int e = eh; e < eh + 8; ++e) {
                    const f32x4 w = *(const LAS f32x4*)(rwq + 256 * q + e * 1024);
                    t0[e] += (h0.x * w.x + h0.y * w.y) + (h0.z * w.z + h0.w * w.w);
                    t1[e] += (h1.x * w.x + h1.y * w.y) + (h1.z * w.z + h1.w * w.w);
                }
            }
        }
        const float l0 = reduce16(t0, lane), l1 = reduce16(t1, lane);
        float m0 = l0, m1 = l1;
#pragma unroll
        for (int o = 4; o < 64; o <<= 1) { m0 = fmaxf(m0, __shfl_xor(m0, o)); m1 = fmaxf(m1, __shfl_xor(m1, o)); }
        const float e0 = expf(l0 - m0), e1 = expf(l1 - m1);
        float s0 = e0, s1 = e1;
#pragma unroll
        for (int o = 4; o < 64; o <<= 1) { s0 += __shfl_xor(s0, o); s1 += __shfl_xor(s1, o); }
        if ((lane & 3) == 0) { typedef float f32x2s_t __attribute__((ext_vector_type(2))); *(f32x2s_t*)(AFF + (size_t)(lane >> 2) * MT + row) = (f32x2s_t){e0 / s0, e1 / s1}; }
    }
}

__device__ __forceinline__ int block_excl_scan(int val, LAS unsigned* tmp, int lane, int wave, int& total) {
    int inc = val;
#pragma unroll
    for (int d = 1; d < 64; d <<= 1) { const int t = __shfl_up(inc, d); if (lane >= d) inc += t; }
    if (lane == 63) tmp[wave] = (unsigned)inc;
    __syncthreads();
    int woff = 0, tot = 0;
#pragma unroll
    for (int w = 0; w < 8; ++w) { const int x = (int)tmp[w]; woff += (w < wave) ? x : 0; tot += x; }
    __syncthreads();
    total = tot;
    return woff + inc - val;
}
__device__ __forceinline__ void topk_task(const Ctx& a, LAS unsigned char* lds, int b, int e, bool isctx, int tid) {
    const int lane = tid & 63, wave = tid >> 6;
    const int Lr = isctx ? LC_ : L_, cap = isctx ? CAP_C : CAP_L;
    const int row0 = isctx ? NLAT + b * LC_ : b * L_;
    const int slot0 = isctx ? NB_ * CAP_L + b * CAP_C : b * CAP_L;
    LAS unsigned* wsum = (LAS unsigned*)lds;
    LAS unsigned* tmp = wsum + 16;
    const float* AFF = (const float*)(a.ws() + WS_AFF);
    int* IDX = (int*)(a.ws() + WS_IDX); float* GATE = (float*)(a.ws() + WS_GATE); int* INV = (int*)(a.ws() + WS_INV);
    unsigned key[4];
#pragma unroll
    for (int i = 0; i < 4; ++i) key[i] = 0u;
    if (4 * tid < Lr) { const v4u kv = *(const v4u*)(AFF + (size_t)e * MT + row0 + 4 * tid); key[0] = kv.x; key[1] = kv.y; key[2] = kv.z; key[3] = kv.w; }
    unsigned T = 0u;
    typedef unsigned v4u_t __attribute__((ext_vector_type(4)));
    LAS v4u_t* wcnt = (LAS v4u_t*)(lds + 256);
#pragma unroll 1
    for (int it = 0; it < 16; ++it) {
        const int sh = 30 - 2 * it;
        const unsigned c1 = T | (1u << sh), c2 = T | (2u << sh), c3 = T | (3u << sh);
        int n1 = 0, n2 = 0, n3 = 0;
#pragma unroll
        for (int i = 0; i < 4; ++i) {
            n1 += __builtin_popcountll(__builtin_amdgcn_ballot_w64(key[i] >= c1));
            n2 += __builtin_popcountll(__builtin_amdgcn_ballot_w64(key[i] >= c2));
            n3 += __builtin_popcountll(__builtin_amdgcn_ballot_w64(key[i] >= c3));
        }
        if (lane == 0) wcnt[(it & 1) * 8 + wave] = (v4u_t){(unsigned)n1, (unsigned)n2, (unsigned)n3, 0u};
        __syncthreads();
        unsigned t1 = 0, t2 = 0, t3 = 0;
#pragma unroll
        for (int w = 0; w < 8; ++w) { const v4u_t x = wcnt[(it & 1) * 8 + w]; t1 += x.x; t2 += x.y; t3 += x.z; }
        T = (t3 >= (unsigned)cap) ? c3 : (t2 >= (unsigned)cap) ? c2 : (t1 >= (unsigned)cap) ? c1 : T;
    }
    __syncthreads();
    const int ngt_mine = (key[0] > T) + (key[1] > T) + (key[2] > T) + (key[3] > T);
    const int neq_mine = (key[0] == T) + (key[1] == T) + (key[2] == T) + (key[3] == T);
    int ngt_tot, neq_tot;
    (void)block_excl_scan(ngt_mine, tmp, lane, wave, ngt_tot);
    int eqrank = block_excl_scan(neq_mine, tmp, lane, wave, neq_tot);
    const int need_eq = cap - ngt_tot;
    bool sel[4]; int nsel = 0;
#pragma unroll
    for (int i = 0; i < 4; ++i) {
        const bool eq = key[i] == T;
        sel[i] = (key[i] > T) || (eq && eqrank < need_eq);
        eqrank += eq ? 1 : 0; nsel += sel[i] ? 1 : 0;
    }
    int seltot;
    int slot = block_excl_scan(nsel, tmp, lane, wave, seltot);
    int iv[4];
#pragma unroll
    for (int i = 0; i < 4; ++i) {
        const int t = 4 * tid + i;
        iv[i] = -1;
        if (t < Lr && sel[i]) {
            const int row = row0 + t;
            IDX[e * SLOTS + slot0 + slot] = row; GATE[e * SLOTS + slot0 + slot] = __uint_as_float(key[i]);
            iv[i] = slot0 + slot; ++slot;
        }
    }
    if (4 * tid < Lr) *(v4u*)(INV + (size_t)e * MT + row0 + 4 * tid) = (v4u){(unsigned)iv[0], (unsigned)iv[1], (unsigned)iv[2], (unsigned)iv[3]};
    __syncthreads();
}
__device__ __forceinline__ void p_topk(const Ctx& a, LAS unsigned char* lds, int layer, int tid) {
    const int ntask = (layer == 0) ? 512 : 256;
    for (int t = blockIdx.x; t < ntask; t += gridDim.x) {
        const bool isctx = t >= 256; const int u = t & 255;
        topk_task(a, lds, u >> 4, u & 15, isctx, tid);
    }
}

__device__ __forceinline__ void unpack8(v4u w, float (&o)[8]) {
    o[0] = bf2f(w.x & 0xffffu); o[1] = bf2f(w.x >> 16); o[2] = bf2f(w.y & 0xffffu); o[3] = bf2f(w.y >> 16);
    o[4] = bf2f(w.z & 0xffffu); o[5] = bf2f(w.z >> 16); o[6] = bf2f(w.w & 0xffffu); o[7] = bf2f(w.w >> 16);
}
__device__ __forceinline__ void p_shortconv(const Ctx& a, int layer, int tid, int bidx, int nblk) {
    const bf16* PROJ = (const bf16*)(a.ws() + WS_PROJ); bf16* YM = (bf16*)(a.ws() + WS_YMIX);
    const int nrows = (layer == 0) ? MT : NLAT;
    const float* w = a.in(18) + layer * 3 * 256; const float* bb = a.in(19) + layer * 256;
    for (int i = bidx * 512 + tid; i < (nrows / 8) * 32; i += nblk * 512) {
        const int row0 = (i >> 5) * 8, cg = i & 31;
        const bool isctx = row0 >= NLAT;
        const int t0 = isctx ? ((row0 - NLAT) & (LC_ - 1)) : (row0 & (L_ - 1)); const int Lr = isctx ? LC_ : L_;
        const bf16* p = PROJ + (size_t)row0 * NP + cg * 8;
        v4u c4[10], x4[10], b4[8];
#pragma unroll
        for (int d = 0; d < 10; ++d) {
            const int tt = t0 + d - 1; const bool ok = (tt >= 0 && tt < Lr);
            c4[d] = ok ? *(const v4u*)(p + (ptrdiff_t)(d - 1) * NP + PSC) : (v4u){0u, 0u, 0u, 0u};
            x4[d] = ok ? *(const v4u*)(p + (ptrdiff_t)(d - 1) * NP + PSX) : (v4u){0u, 0u, 0u, 0u};
        }
#pragma unroll
        for (int d = 0; d < 8; ++d) b4[d] = *(const v4u*)(p + (size_t)d * NP + PSB);
        float w0[8], w1[8], w2[8], bv[8];
#pragma unroll
        for (int q = 0; q < 8; ++q) { w0[q] = w[cg * 8 + q]; w1[q] = w[256 + cg * 8 + q]; w2[q] = w[512 + cg * 8 + q]; bv[q] = bb[cg * 8 + q]; }
        float up[8], uc[8], un[8];
        { float cf[8], xf[8]; unpack8(c4[0], cf); unpack8(x4[0], xf);
#pragma unroll
          for (int q = 0; q < 8; ++q) up[q] = cf[q] * xf[q];
          unpack8(c4[1], cf); unpack8(x4[1], xf);
#pragma unroll
          for (int q = 0; q < 8; ++q) uc[q] = cf[q] * xf[q]; }
#pragma unroll
        for (int d = 0; d < 8; ++d) {
            float cf[8], xf[8], bg[8], o[8];
            unpack8(c4[d + 2], cf); unpack8(x4[d + 2], xf); unpack8(b4[d], bg);
#pragma unroll
            for (int q = 0; q < 8; ++q) { un[q] = cf[q] * xf[q]; o[q] = bg[q] * (w0[q] * up[q] + w1[q] * uc[q] + w2[q] * un[q] + bv[q]); up[q] = uc[q]; uc[q] = un[q]; }
            v4u r; r.x = pk2(o[0], o[1]); r.y = pk2(o[2], o[3]); r.z = pk2(o[4], o[5]); r.w = pk2(o[6], o[7]);
            *(v4u*)(YM + (size_t)(row0 + d) * D_ + 768 + cg * 8) = r;
        }
    }
}
__device__ __forceinline__ void conf_tile(const Ctx& a, LAS unsigned char* lds, int layer, int tile, int tid) {
    const int lane = tid & 63, wave = tid >> 6;
    const bf16* PROJ = (const bf16*)(a.ws() + WS_PROJ); bf16* YM = (bf16*)(a.ws() + WS_YMIX);
    bool isctx; int r0, t0;
    if (tile < 512) { isctx = false; r0 = (tile >> 5) * L_ + (tile & 31) * 64; t0 = 0; }
    else { const int u = tile - 512; isctx = true; t0 = (u & 3) * 64; r0 = NLAT + (u >> 2) * LC_ + t0; }
    LAS float* zt = (LAS float*)lds;
    __syncthreads();
    {
        v4u a4[6], g4[6];
#pragma unroll
        for (int it = 0; it < 6; ++it) {
            const int i = tid + 512 * it; const int idx = i >> 5, cg = i & 31, rel = idx - 15;
            const bool valid = (i < 94 * 32) && (isctx ? (t0 + rel >= 0 && t0 + rel < LC_) : (rel >= 0 && rel < 64));
            const bf16* p = PROJ + (size_t)(r0 + rel) * NP + cg * 8;
            a4[it] = valid ? *(const v4u*)(p + PCA) : (v4u){0u, 0u, 0u, 0u};
            g4[it] = valid ? *(const v4u*)(p + PCG) : (v4u){0u, 0u, 0u, 0u};
        }
#pragma unroll
        for (int it = 0; it < 6; ++it) {
            const int i = tid + 512 * it; const int idx = i >> 5, cg = i & 31;
            if (i < 94 * 32) {
                float af[8], gf[8]; unpack8(a4[it], af); unpack8(g4[it], gf);
                float z[8];
#pragma unroll
                for (int q = 0; q < 8; ++q) z[q] = af[q] * sigm(gf[q]);
                *(LAS f32x4*)(zt + idx * 256 + cg * 8) = (f32x4){z[0], z[1], z[2], z[3]};
                *(LAS f32x4*)(zt + idx * 256 + cg * 8 + 4) = (f32x4){z[4], z[5], z[6], z[7]};
            }
        }
    }
    __syncthreads();
    const int c = tid & 255, half = tid >> 8;
    float w[31];
    const float* cw = a.in(9) + (size_t)layer * 31 * 256 + c;
#pragma unroll
    for (int j = 0; j < 31; ++j) w[j] = cw[j * 256];
    const float bias = a.in(10)[layer * 256 + c];
    float out[32];
#pragma unroll
    for (int g4 = 0; g4 < 8; ++g4) {
        float win[34];
#pragma unroll
        for (int q = 0; q < 34; ++q) win[q] = zt[(half * 32 + g4 * 4 + q) * 256 + c];
#pragma unroll
        for (int u = 0; u < 4; ++u) {
            float acc = bias;
#pragma unroll
            for (int j = 0; j < 31; ++j) acc += w[j] * win[u + j];
            out[g4 * 4 + u] = acc;
        }
    }
    __syncthreads();
#pragma unroll
    for (int tt = 0; tt < 32; ++tt) zt[(half * 32 + tt) * 256 + c] = out[tt];
    __syncthreads();
    const f32x4 lw = *(const f32x4*)(a.in(11) + layer * 256 + 4 * lane), lb = *(const f32x4*)(a.in(12) + layer * 256 + 4 * lane);
    {
        f32x4 x[8]; float s1[8], s2[8];
#pragma unroll
        for (int i = 0; i < 8; ++i) { x[i] = *(const LAS f32x4*)(zt + (wave + 8 * i) * 256 + 4 * lane); s1[i] = (x[i].x + x[i].y) + (x[i].z + x[i].w); s2[i] = (x[i].x * x[i].x + x[i].y * x[i].y) + (x[i].z * x[i].z + x[i].w * x[i].w); }
#pragma unroll
        for (int o = 1; o < 64; o <<= 1)
#pragma unroll
            for (int i = 0; i < 8; ++i) { s1[i] += __shfl_xor(s1[i], o); s2[i] += __shfl_xor(s2[i], o); }
#pragma unroll
        for (int i = 0; i < 8; ++i) {
            const float mean = s1[i] * (1.f / 256.f); const float var = fmaxf(s2[i] * (1.f / 256.f) - mean * mean, 0.f);
            const f32x4 y = (x[i] - mean) * rsqrtf(var + EPS) * lw + lb;
            const f32x4 o = (f32x4){silu(y.x), silu(y.y), silu(y.z), silu(y.w)};
            *(v2u*)(YM + (size_t)(r0 + wave + 8 * i) * D_ + 4 * lane) = pack4(o);
        }
    }
}
#define ZERO16 (f32x16){0.f,0.f,0.f,0.f,0.f,0.f,0.f,0.f,0.f,0.f,0.f,0.f,0.f,0.f,0.f,0.f}
typedef short s16x8 __attribute__((ext_vector_type(8)));
constexpr int GL_QD = 0, GL_KD = 4608, GL_FR = 9216, GL_EG = 13312, GL_SLOT = 13824;
typedef float f32x2_t __attribute__((ext_vector_type(2))); typedef __bf16 bf16x2_t __attribute__((ext_vector_type(2)));
__device__ __forceinline__ unsigned cvtpk(float lo, float hi) { f32x2_t v = {lo, hi}; bf16x2_t b = __builtin_convertvector(v, bf16x2_t); return __builtin_bit_cast(unsigned, b); }
__device__ __forceinline__ s16x8 pack8(const f32x16& x, int s) {
    v4u w; w.x = cvtpk(x[8 * s + 0], x[8 * s + 1]); w.y = cvtpk(x[8 * s + 2], x[8 * s + 3]); w.z = cvtpk(x[8 * s + 4], x[8 * s + 5]); w.w = cvtpk(x[8 * s + 6], x[8 * s + 7]);
    return __builtin_bit_cast(s16x8, w);
}
#define GL_BAR() do { asm volatile("s_waitcnt lgkmcnt(0)" ::: "memory"); __builtin_amdgcn_s_barrier(); asm volatile("" ::: "memory"); } while (0)
__device__ __forceinline__ int gla_row0(int b, int dir, int c) {
    return (c < 8) ? (NLAT + b * LC_ + (dir ? (LC_ - 1 - 32 * c) : 32 * c)) : (b * L_ + (dir ? (L_ - 1 - 32 * (c - 8)) : 32 * (c - 8)));
}
__device__ __forceinline__ void gla_fast_task(const Ctx& a, LAS unsigned char* lds, int layer, int task, int tid) {
    const int dir = task & 1, h = (task >> 1) & 3, b = task >> 3;
    const int lane = tid & 63, wave = __builtin_amdgcn_readfirstlane(tid >> 6);
    const int n = lane & 31, hh = lane >> 5;
    const bf16* PROJ = (const bf16*)(a.ws() + WS_PROJ);
    const int sgn = dir ? -1 : 1;
    __syncthreads();
    if (wave < 4) {
        const int cc = wave >> 1, dt = wave & 1;
        const int dkl = 32 * dt + n;
        const float* wa = a.in(dir ? 15 : 13) + layer * 16 * 256 + h * 64 + dkl;
        const float bav = a.in(dir ? 16 : 14)[layer * 256 + h * 64 + dkl];
        const int afoff = dir ? PAB : PAF;
        s16x8 wah, wal;
        {
            float wv[8]; unsigned hi[8], lo[8];
#pragma unroll
            for (int j = 0; j < 8; ++j) { wv[j] = wa[(8 * hh + j) * 256]; hi[j] = f2bf(wv[j]); lo[j] = f2bf(wv[j] - bf2f(hi[j])); }
            v4u wh, wl;
            wh.x = hi[0] | (hi[1] << 16); wh.y = hi[2] | (hi[3] << 16); wh.z = hi[4] | (hi[5] << 16); wh.w = hi[6] | (hi[7] << 16);
            wl.x = lo[0] | (lo[1] << 16); wl.y = lo[2] | (lo[3] << 16); wl.z = lo[4] | (lo[5] << 16); wl.w = lo[6] | (lo[7] << 16);
            wah = __builtin_bit_cast(s16x8, wh); wal = __builtin_bit_cast(s16x8, wl);
        }
        v4u afr_n; unsigned qr_n[16], kr_n[16];
        const __amdgpu_buffer_rsrc_t prs = __builtin_amdgcn_make_buffer_rsrc((void*)(((unsigned long long)(unsigned)__builtin_amdgcn_readfirstlane((int)(unsigned)((unsigned long long)PROJ >> 32)) << 32) | (unsigned)__builtin_amdgcn_readfirstlane((int)(unsigned)(unsigned long long)PROJ)), 0, 0x7fffffff, 0x00020000);
        const unsigned afl = (unsigned)(((dir ? 31 - n : n) * NP + afoff + 8 * hh) * 2), ql = (unsigned)(((dir ? 4 - 4 * hh : 4 * hh) * NP + PQ + h * 64 + dkl) * 2), kl = (unsigned)(((dir ? 4 - 4 * hh : 4 * hh) * NP + PK + h * 64 + dkl) * 2);
        const int afb = dir ? -31 * NP * 2 : 0, qkb = dir ? -4 * NP * 2 : 0;
        {
            const int prow = gla_row0(b, dir, cc) * (NP * 2);
            afr_n = __builtin_bit_cast(v4u, __builtin_amdgcn_raw_buffer_load_b128(prs, afl, prow + afb, 0));
#pragma unroll
            for (int r = 0; r < 16; ++r) { const int so = prow + qkb + sgn * ((r & 3) + 8 * (r >> 2)) * (NP * 2); qr_n[r] = __builtin_amdgcn_raw_buffer_load_b16(prs, ql, so, 0); kr_n[r] = __builtin_amdgcn_raw_buffer_load_b16(prs, kl, so, 0); }
        }
        for (int i = 0; i <= 36; ++i) {
            if (i < 36) {
                LAS unsigned char* sl = lds + ((i & 1) * 2 + cc) * GL_SLOT;
                const v4u afr = afr_n; unsigned qr[16], kr[16];
#pragma unroll
                for (int r = 0; r < 16; ++r) { qr[r] = qr_n[r]; kr[r] = kr_n[r]; }
                if (i + 1 < 36) {
                    const int prow = gla_row0(b, dir, 2 * (i + 1) + cc) * (NP * 2);
                    afr_n = __builtin_bit_cast(v4u, __builtin_amdgcn_raw_buffer_load_b128(prs, afl, prow + afb, 0));
#pragma unroll
                    for (int r = 0; r < 16; ++r) { const int so = prow + qkb + sgn * ((r & 3) + 8 * (r >> 2)) * (NP * 2); qr_n[r] = __builtin_amdgcn_raw_buffer_load_b16(prs, ql, so, 0); kr_n[r] = __builtin_amdgcn_raw_buffer_load_b16(prs, kl, so, 0); }
                }
                f32x16 Z = ZERO16;
                Z = __builtin_amdgcn_mfma_f32_32x32x16_bf16(__builtin_bit_cast(s16x8, afr), wah, Z, 0, 0, 0);
                Z = __builtin_amdgcn_mfma_f32_32x32x16_bf16(__builtin_bit_cast(s16x8, afr), wal, Z, 0, 0, 0);
                float p[16];
#pragma unroll
                for (int r = 0; r < 16; ++r) { const float z = Z[r] + bav; p[r] = fminf(z, 0.f) * (1.f / 16.f) - __builtin_amdgcn_logf(1.f + __builtin_amdgcn_exp2f(-1.4426950408889634f * fabsf(z))) * (0.6931471805599453f / 16.f); }
                float G[4], Gp[4];
#pragma unroll
                for (int g = 0; g < 4; ++g) { p[4 * g + 1] += p[4 * g]; p[4 * g + 2] += p[4 * g + 1]; p[4 * g + 3] += p[4 * g + 2]; G[g] = p[4 * g + 3]; }
#pragma unroll
                for (int g = 0; g < 4; ++g) Gp[g] = __shfl_xor(G[g], 32);
                float off = 0.f;
#pragma unroll
                for (int g = 0; g < 4; ++g) {
                    const float o_g = off + (hh ? Gp[g] : 0.f);
#pragma unroll
                    for (int q = 0; q < 4; ++q) p[4 * g + q] += o_g;
                    off += G[g] + Gp[g];
                }
                f32x16 kd;
#pragma unroll
                for (int r = 0; r < 16; ++r) {
                    const int t = (r & 3) + 8 * (r >> 2) + 4 * hh;
                    const float E = __builtin_amdgcn_exp2f(p[r] * 1.4426950408889634f);
                    const float qd = bf2f(qr[r]) * 0.125f * E; const float kdv = bf2f(kr[r]) * __builtin_amdgcn_rcpf(E);
                    kd[r] = kdv;
                    const unsigned qk = cvtpk(qd, kdv);
                    *(LAS unsigned short*)(sl + GL_QD + t * 144 + dkl * 2) = (unsigned short)(qk & 0xffffu);
                    *(LAS unsigned short*)(sl + GL_KD + t * 144 + dkl * 2) = (unsigned short)(qk >> 16);
                }
                *(LAS s16x8*)(sl + GL_FR + ((dt * 2 + 0) * 64 + lane) * 16) = pack8(kd, 0);
                *(LAS s16x8*)(sl + GL_FR + ((dt * 2 + 1) * 64 + lane) * 16) = pack8(kd, 1);
                if (hh == 0) *(LAS float*)(sl + GL_EG + dkl * 4) = __builtin_amdgcn_exp2f(off * 1.4426950408889634f);
            }
            GL_BAR();
        }
    } else {
        const int n0 = 32 * (wave - 4);
        const char* Vb = (const char*)(PROJ + PV + h * 128 + n0);
        char* Ob = (char*)((bf16*)(a.ws() + WS_OGLA) + (size_t)dir * MT * 512 + h * 128 + n0);
        const int vl = (sgn * 4 * hh * NP + n) * 2, ol = (sgn * 4 * hh * 512 + n) * 2;
        f32x16 S0 = ZERO16, S1 = ZERO16;
        unsigned vr_n[2][16];
#pragma unroll
        for (int cc = 0; cc < 2; ++cc)
#pragma unroll
            for (int r = 0; r < 16; ++r) vr_n[cc][r] = 0u;
        for (int i = 0; i <= 36; ++i) {
            unsigned vr[2][16];
#pragma unroll
            for (int cc = 0; cc < 2; ++cc)
#pragma unroll
                for (int r = 0; r < 16; ++r) vr[cc][r] = vr_n[cc][r];
            if (i < 36) {
#pragma unroll
                for (int cc = 0; cc < 2; ++cc) {
                    const char* vrow = Vb + (size_t)gla_row0(b, dir, 2 * i + cc) * (NP * 2);
#pragma unroll
                    for (int r = 0; r < 16; ++r) vr_n[cc][r] = *(const bf16*)(vrow + (vl + sgn * ((r & 3) + 8 * (r >> 2)) * (NP * 2)));
                }
            }
            if (i >= 1) {
                const LAS unsigned char* slb = lds + ((i - 1) & 1) * 2 * GL_SLOT;
                s16x8 vb[2][2];
#pragma unroll
                for (int cc = 0; cc < 2; ++cc)
#pragma unroll
                    for (int s2 = 0; s2 < 2; ++s2) {
                        v4u w; w.x = vr[cc][8 * s2 + 0] | (vr[cc][8 * s2 + 1] << 16); w.y = vr[cc][8 * s2 + 2] | (vr[cc][8 * s2 + 3] << 16);
                        w.z = vr[cc][8 * s2 + 4] | (vr[cc][8 * s2 + 5] << 16); w.w = vr[cc][8 * s2 + 6] | (vr[cc][8 * s2 + 7] << 16);
                        vb[cc][s2] = __builtin_bit_cast(s16x8, w);
                    }
                f32x16 o[2];
#pragma unroll
                for (int cc = 0; cc < 2; ++cc) {
                    const LAS unsigned char* sl = slb + cc * GL_SLOT;
                    f32x16 PT = ZERO16;
#pragma unroll
                    for (int s4 = 0; s4 < 4; ++s4) {
                        const s16x8 ak = *(const LAS s16x8*)(sl + GL_KD + n * 144 + (16 * s4 + 8 * hh) * 2);
                        const s16x8 bq = *(const LAS s16x8*)(sl + GL_QD + n * 144 + (16 * s4 + 8 * hh) * 2);
                        PT = __builtin_amdgcn_mfma_f32_32x32x16_bf16(ak, bq, PT, 0, 0, 0);
                    }
#pragma unroll
                    for (int r = 0; r < 16; ++r) { const int j = (r & 3) + 8 * (r >> 2) + 4 * hh; PT[r] = (j <= n) ? PT[r] : 0.f; }
                    o[cc] = ZERO16;
                    o[cc] = __builtin_amdgcn_mfma_f32_32x32x16_bf16(pack8(PT, 0), vb[cc][0], o[cc], 0, 0, 0);
                    o[cc] = __builtin_amdgcn_mfma_f32_32x32x16_bf16(pack8(PT, 1), vb[cc][1], o[cc], 0, 0, 0);
                }
#pragma unroll
                for (int cc = 0; cc < 2; ++cc) {
                    const int c = 2 * (i - 1) + cc;
                    const LAS unsigned char* sl = slb + cc * GL_SLOT;
                    f32x16 d0 = ZERO16, d1 = ZERO16;
#pragma unroll
                    for (int s2 = 0; s2 < 2; ++s2) {
                        d0 = __builtin_amdgcn_mfma_f32_32x32x16_bf16(*(const LAS s16x8*)(sl + GL_FR + ((0 * 2 + s2) * 64 + lane) * 16), vb[cc][s2], d0, 0, 0, 0);
                        d1 = __builtin_amdgcn_mfma_f32_32x32x16_bf16(*(const LAS s16x8*)(sl + GL_FR + ((1 * 2 + s2) * 64 + lane) * 16), vb[cc][s2], d1, 0, 0, 0);
                    }
#pragma unroll
                    for (int dt = 0; dt < 2; ++dt)
#pragma unroll
                        for (int s2 = 0; s2 < 2; ++s2) {
                            const v2u a0 = *(const LAS v2u*)(sl + GL_QD + n * 144 + (32 * dt + 16 * s2 + 4 * hh) * 2);
                            const v2u a1 = *(const LAS v2u*)(sl + GL_QD + n * 144 + (32 * dt + 16 * s2 + 8 + 4 * hh) * 2);
                            const v4u aw = (v4u){a0.x, a0.y, a1.x, a1.y};
                            o[cc] = __builtin_amdgcn_mfma_f32_32x32x16_bf16(__builtin_bit_cast(s16x8, aw), pack8(dt ? S1 : S0, s2), o[cc], 0, 0, 0);
                        }
#pragma unroll
                    for (int g = 0; g < 4; ++g) {
                        const f32x4 e0 = *(const LAS f32x4*)(sl + GL_EG + (8 * g + 4 * hh) * 4), e1 = *(const LAS f32x4*)(sl + GL_EG + (32 + 8 * g + 4 * hh) * 4);
                        S0[4 * g + 0] = e0.x * (S0[4 * g + 0] + d0[4 * g + 0]); S0[4 * g + 1] = e0.y * (S0[4 * g + 1] + d0[4 * g + 1]);
                        S0[4 * g + 2] = e0.z * (S0[4 * g + 2] + d0[4 * g + 2]); S0[4 * g + 3] = e0.w * (S0[4 * g + 3] + d0[4 * g + 3]);
                        S1[4 * g + 0] = e1.x * (S1[4 * g + 0] + d1[4 * g + 0]); S1[4 * g + 1] = e1.y * (S1[4 * g + 1] + d1[4 * g + 1]);
                        S1[4 * g + 2] = e1.z * (S1[4 * g + 2] + d1[4 * g + 2]); S1[4 * g + 3] = e1.w * (S1[4 * g + 3] + d1[4 * g + 3]);
                    }
                    if (!(layer == 1 && c < 8)) {
                        char* orow = Ob + (size_t)gla_row0(b, dir, c) * (512 * 2);
#pragma unroll
                        for (int r = 0; r < 16; ++r) *(bf16*)(orow + (ol + sgn * ((r & 3) + 8 * (r >> 2)) * (512 * 2))) = (bf16)(cvtpk(o[cc][r], o[cc][r]) & 0xffffu);
                    }
                }
            }
            GL_BAR();
        }
    }
    asm volatile("s_waitcnt vmcnt(0)" ::: "memory");
    __syncthreads();
}
__device__ __forceinline__ void p_mix(const Ctx& a, LAS unsigned char* lds, int layer, int tid) {
    const int G = gridDim.x;
    if (G >= 256) {
#ifndef MIXREP_GLA
#define MIXREP_GLA 1
#endif
#ifndef MIXREP_CONF
#define MIXREP_CONF 1
#endif
#ifndef MIXREP_SC
#define MIXREP_SC 1
#endif
        if ((int)blockIdx.x < 128) { for (int rp = 0; rp < MIXREP_GLA; ++rp) gla_fast_task(a, lds, layer, blockIdx.x, tid); return; }
        const int cb = blockIdx.x - 128, ncb = G - 128;
        const int ntile = (layer == 0) ? 576 : 512;
        for (int rp = 0; rp < MIXREP_CONF; ++rp) for (int t = cb; t < ntile; t += ncb) conf_tile(a, lds, layer, t, tid);
        for (int rp = 0; rp < MIXREP_SC; ++rp) p_shortconv(a, layer, tid, cb, ncb);
        return;
    }
    for (int t = blockIdx.x; t < 128; t += G) gla_fast_task(a, lds, layer, t, tid);
    const int ntile = (layer == 0) ? 576 : 512;
    for (int t = blockIdx.x; t < ntile; t += gridDim.x) conf_tile(a, lds, layer, t, tid);
    p_shortconv(a, layer, tid, blockIdx.x, gridDim.x);
}
__device__ __forceinline__ void p_glaout(const Ctx& a, int layer, int tid) {
    const int lane = tid & 63, wave = tid >> 6, gw = blockIdx.x * NWAVES + wave, NGW = gridDim.x * NWAVES;
    const bf16* PROJ = (const bf16*)(a.ws() + WS_PROJ); bf16* YM = (bf16*)(a.ws() + WS_YMIX);
    const bf16* OG0 = (const bf16*)(a.ws() + WS_OGLA); const bf16* OG1 = OG0 + (size_t)MT * 512;
    const int nrows = (layer == 0) ? MT : NLAT;
    const float* gn = a.in(17) + layer * 512 + 8 * lane;
    const f32x4 g0 = *(const f32x4*)gn, g1 = *(const f32x4*)(gn + 4);
    const float gv[8] = {g0.x, g0.y, g0.z, g0.w, g1.x, g1.y, g1.z, g1.w};
    const int ntrips = nrows / 2;
    v4u nf[2], nb[2], nr[2];
    auto issue = [&](int t) {
#pragma unroll
        for (int i = 0; i < 2; ++i) { const size_t row = (size_t)(2 * t + i);
            nf[i] = *(const v4u*)(OG0 + row * 512 + 8 * lane); nb[i] = *(const v4u*)(OG1 + row * 512 + 8 * lane); nr[i] = *(const v4u*)(PROJ + row * NP + PR + 8 * lane); }
    };
    if (gw < ntrips) issue(gw);
    for (int t = gw; t < ntrips; t += NGW) {
        v4u cf[2], cb[2], cr[2];
#pragma unroll
        for (int i = 0; i < 2; ++i) { cf[i] = nf[i]; cb[i] = nb[i]; cr[i] = nr[i]; }
        if (t + NGW < ntrips) issue(t + NGW);
        __builtin_amdgcn_sched_barrier(0);
#pragma unroll
        for (int i = 0; i < 2; ++i) {
            const int row = 2 * t + i;
            const unsigned fw[4] = {cf[i].x, cf[i].y, cf[i].z, cf[i].w}, bw[4] = {cb[i].x, cb[i].y, cb[i].z, cb[i].w}, rw[4] = {cr[i].x, cr[i].y, cr[i].z, cr[i].w};
            float o[8], r[8]; float ss = 0.f;
#pragma unroll
            for (int q = 0; q < 4; ++q) {
                o[2 * q] = bf2f(fw[q] & 0xffffu) + bf2f(bw[q] & 0xffffu); o[2 * q + 1] = bf2f(fw[q] >> 16) + bf2f(bw[q] >> 16);
                r[2 * q] = bf2f(rw[q] & 0xffffu); r[2 * q + 1] = bf2f(rw[q] >> 16);
                ss += o[2 * q] * o[2 * q] + o[2 * q + 1] * o[2 * q + 1];
            }
            ss += __shfl_xor(ss, 1); ss += __shfl_xor(ss, 2); ss += __shfl_xor(ss, 4); ss += __shfl_xor(ss, 8);
            const float rstd = rsqrtf(ss * (1.f / 128.f) + EPS);
            float y[8];
#pragma unroll
            for (int q = 0; q < 8; ++q) y[q] = o[q] * rstd * gv[q] * silu(r[q]);
            v4u w; w.x = pk2(y[0], y[1]); w.y = pk2(y[2], y[3]); w.z = pk2(y[4], y[5]); w.w = pk2(y[6], y[7]);
            *(v4u*)(YM + (size_t)row * D_ + 256 + 8 * lane) = w;
        }
    }
}

namespace pg8 {
#define PG8_LAS __attribute__((address_space(3)))
typedef unsigned short bf16_t;
typedef short bf16x8 __attribute__((ext_vector_type(8)));
typedef float f32x4 __attribute__((ext_vector_type(4)));
typedef unsigned u32x4 __attribute__((ext_vector_type(4)));
constexpr int BM = 256, BK = 64, HALF = 128, HTB = HALF * BK * 2  , STAGE_BYTES = 8 * HTB, NXCD = 8, WGM = 8;

__host__ __device__ __forceinline__ int lds_byte(int r, int c) { const int st = (r >> 4) * 2 + (c >> 5), rr = r & 15, cc = c & 31, ob = rr * 64 + cc * 2; return st * 1024 + (ob ^ (((ob >> 9) & 1) << 5)); }
__host__ __device__ __forceinline__ void stage_rc(int b, int& R, int& C) { const int st = b / 1024, sb = b % 1024, swz = sb ^ (((sb >> 9) & 1) << 5); R = (st >> 1) * 16 + swz / 64; C = (st & 1) * 32 + (swz % 64) / 2; }
__host__ __device__ __forceinline__ int perm32(int rho) { const int n = rho >> 4, i = rho & 15; return 8 * (i >> 2) + 4 * n + (i & 3); }

struct Unit { int pm, pn; };
struct Gemm { const bf16_t* A; const bf16_t* Bt; int M, N, K; };

struct StaticOrder {
    int nM, nN, nwg, G, c;
    __host__ __device__ void init(int M, int N, int G_, int c_) { nM = M / BM; nN = N / BM; nwg = nM * nN; G = G_; c = c_; }
    __host__ __device__ bool next(int i, Unit& u) const {
        const long L = (long)i * G + c; if (L >= nwg) return false;
        int wgid = (int)L; { const int q = nwg / NXCD, r = nwg % NXCD, xcd = wgid % NXCD, off = wgid / NXCD; wgid = (xcd < r ? xcd * (q + 1) : r * (q + 1) + (xcd - r) * q) + off; }
        const int nig = WGM * nN, gid = wgid / nig, fm = gid * WGM, gsz = (nM - fm) < WGM ? (nM - fm) : WGM;
        u.pm = fm + ((wgid % nig) % gsz); u.pn = (wgid % nig) / gsz; return true;
    }
    __device__ __forceinline__ void a_ready(const Unit&) const {}
    __device__ __forceinline__ void done(const Unit&) const {}
};


typedef float f32x2c_t __attribute__((ext_vector_type(2))); typedef __bf16 bf16x2c_t __attribute__((ext_vector_type(2)));
__device__ __forceinline__ unsigned cvt_pk_bf16(float lo, float hi) { f32x2c_t v = {lo, hi}; bf16x2c_t b = __builtin_convertvector(v, bf16x2c_t); return __builtin_bit_cast(unsigned, b); }
template <class Epi, class Sched, bool ALIGN_EPI = false, bool SP2 = false, bool FP8 = false>
__device__ __forceinline__ void gemm_phase(PG8_LAS unsigned char* lds, const Gemm g, const Sched& S, const Epi& E) {
    const int tid = otid(), wid = __builtin_amdgcn_readfirstlane(tid >> 6), lane = tid & 63, wr = wid >> 2, wc = wid & 3, fr = lane & 15, fq = lane >> 4;
    const int K = g.K, nt = K / BK;
    unsigned voffA[2], voffB[2];
#pragma unroll
    for (int i = 0; i < 2; ++i) { int R, C; stage_rc(tid * 16 + i * 8192, R, C); const int Rb = Epi::PERM ? ((R & ~31) + perm32(R & 31)) : R;
        voffA[i] = (unsigned)(R * K + C) * 2u; voffB[i] = (unsigned)(Rb * K + C) * 2u; }
    static_assert(!Sched::GATHER || SP2, "the gathered-A variant is written for the SP2 loop");
    unsigned gA0[2] = {0u, 0u}, gA1[2] = {0u, 0u}, ngA0[2] = {0u, 0u}, ngA1[2] = {0u, 0u};
#define PG8_GOFF(uix, o0, o1) do { _Pragma("unroll") for (int _i = 0; _i < 2; ++_i) { int R_, C_; stage_rc(tid * 16 + _i * 8192, R_, C_); \
        (o0)[_i] = (unsigned)S.arow((uix), R_) * (unsigned)(K * 2) + (unsigned)(C_ * 2); (o1)[_i] = (unsigned)S.arow((uix), HALF + R_) * (unsigned)(K * 2) + (unsigned)(C_ * 2); } } while (0)
#define PG8_STAGE_A0(bufoff, ptr, arr) do { if constexpr (Sched::GATHER) PG8_STAGE(bufoff, ptr, arr); else PG8_STAGE(bufoff, ptr, voffA); } while (0)
#define PG8_STAGE_A1(bufoff, ptr, arr) do { if constexpr (Sched::GATHER) PG8_STAGE(bufoff, ptr, arr); else PG8_STAGE(bufoff, (ptr) + hstep, voffA); } while (0)
    const size_t kstep = (size_t)(BK * 2);
    const size_t hstep = (size_t)HALF * K * 2;
    const size_t tstep = 2 * hstep;
    const unsigned ldsw = (unsigned)wid * 1024u;
    const int aoff = lds_byte(wr * 64 + fr, fq * 8), boff = lds_byte(wc * 32 + fr, fq * 8);
#define PG8_SA(b, h) (((b) * 2 + (h)) * HTB)
#define PG8_SB(b, h) ((4 + (b) * 2 + (h)) * HTB)
#define PG8_STAGE(bufoff, gbase, voff) do { _Pragma("unroll") for (int _i = 0; _i < 2; ++_i) \
        __builtin_amdgcn_global_load_lds((const unsigned*)((const char*)(gbase) + (voff)[_i]), (PG8_LAS unsigned*)(lds + (bufoff) + ldsw + _i * 8192), 16, 0, 0); } while (0)
#define PG8_LDA(dst, b, h) do { _Pragma("unroll") for (int m = 0; m < 4; ++m) { if constexpr (FP8) dst##8[m] = PG8_CAT8(*(const PG8_LAS bf16x8*)(lds + PG8_SA(b, h) + aoff + m * 2048), *(const PG8_LAS bf16x8*)(lds + PG8_SA(b, h) + aoff + m * 2048 + 1024)); \
        else { _Pragma("unroll") for (int k = 0; k < 2; ++k) dst[m][k] = *(const PG8_LAS bf16x8*)(lds + PG8_SA(b, h) + aoff + m * 2048 + k * 1024); } } } while (0)
#define PG8_LDB(dst, b, h) do { _Pragma("unroll") for (int n = 0; n < 2; ++n) { if constexpr (FP8) dst##8[n] = PG8_CAT8(*(const PG8_LAS bf16x8*)(lds + PG8_SB(b, h) + boff + n * 2048), *(const PG8_LAS bf16x8*)(lds + PG8_SB(b, h) + boff + n * 2048 + 1024)); \
        else { _Pragma("unroll") for (int k = 0; k < 2; ++k) dst[n][k] = *(const PG8_LAS bf16x8*)(lds + PG8_SB(b, h) + boff + n * 2048 + k * 1024); } } } while (0)
typedef int v8i_t __attribute__((ext_vector_type(8)));
typedef int v4i_t __attribute__((ext_vector_type(4)));
#define PG8_CAT8(x0, x1) __builtin_shufflevector(__builtin_bit_cast(v4i_t, (x0)), __builtin_bit_cast(v4i_t, (x1)), 0, 1, 2, 3, 4, 5, 6, 7)
#define PG8_MMA(ai, bj, At, Bt) do { __builtin_amdgcn_s_setprio(1); _Pragma("unroll") for (int m = 0; m < 4; ++m) _Pragma("unroll") for (int n = 0; n < 2; ++n) { \
        if constexpr (FP8) asm volatile("v_mfma_f32_16x16x128_f8f6f4 %0, %1, %2, %0" : "+v"(acc[ai][bj][m][n]) : "v"(Bt##8[n]), "v"(At##8[m])); \
        else { _Pragma("unroll") for (int k = 0; k < 2; ++k) acc[ai][bj][m][n] = __builtin_amdgcn_mfma_f32_16x16x32_bf16(Bt[n][k], At[m][k], acc[ai][bj][m][n], 0, 0, 0); } } \
        __builtin_amdgcn_s_setprio(0); } while (0)
#define PG8_WAIT_V(n) asm volatile("s_waitcnt vmcnt(" #n ")" ::: "memory")
#define PG8_WAIT_L(n) asm volatile("s_waitcnt lgkmcnt(" #n ")" ::: "memory")
#define PG8_BAR __builtin_amdgcn_s_barrier()
#define PG8_SCHED __builtin_amdgcn_sched_barrier(0)
    Unit cur, nxt; int ui = 0;
    if (!S.next(0, cur)) return;
    f32x4 acc[2][2][4][2];
#pragma unroll
    for (int a = 0; a < 2; ++a)
#pragma unroll
        for (int b = 0; b < 2; ++b)
#pragma unroll
            for (int m = 0; m < 4; ++m)
#pragma unroll
                for (int n = 0; n < 2; ++n) acc[a][b][m][n] = (f32x4){0.f, 0.f, 0.f, 0.f};
    bf16x8 At[4][2], B0[2][2], B1[2][2];
    v8i_t At8[4], B08[2], B18[2];
    const char* cA = Sched::GATHER ? (const char*)g.A : (const char*)g.A + (size_t)cur.pm * tstep; const char* cB = (const char*)g.Bt + (size_t)cur.pn * tstep;
    if constexpr (Sched::GATHER) PG8_GOFF(0, gA0, gA1);
    S.a_ready(cur);
    if constexpr (SP2) {
        PG8_STAGE(PG8_SB(0, 0), cB, voffB); PG8_STAGE(PG8_SB(0, 1), cB + hstep, voffB); PG8_STAGE_A0(PG8_SA(0, 0), cA, gA0); PG8_STAGE_A1(PG8_SA(0, 1), cA, gA1);
        if (wr == 1) PG8_BAR;
        PG8_WAIT_V(2); PG8_BAR;
        PG8_STAGE(PG8_SB(1, 0), cB + kstep, voffB); PG8_STAGE_A0(PG8_SA(1, 0), cA + kstep, gA0); PG8_STAGE(PG8_SB(1, 1), cB + hstep + kstep, voffB);
        PG8_WAIT_V(6); PG8_BAR;
    } else {
        PG8_STAGE(PG8_SB(0, 0), cB, voffB); PG8_STAGE(PG8_SA(0, 0), cA, voffA); PG8_STAGE(PG8_SB(0, 1), cB + hstep, voffB); PG8_STAGE(PG8_SA(0, 1), cA + hstep, voffA);
        if (wr == 1) PG8_BAR;
        PG8_WAIT_V(4); PG8_BAR;
        PG8_STAGE(PG8_SB(1, 0), cB + kstep, voffB); PG8_STAGE(PG8_SA(1, 0), cA + kstep, voffA); PG8_STAGE(PG8_SB(1, 1), cB + hstep + kstep, voffB);
        PG8_WAIT_V(6); PG8_BAR;
    }
    for (;;) {
        const bool has_next = S.next(ui + 1, nxt);
        const char* nA = (has_next && !Sched::GATHER) ? (const char*)g.A + (size_t)nxt.pm * tstep : cA; const char* nB = has_next ? (const char*)g.Bt + (size_t)nxt.pn * tstep : cB;
        if constexpr (Sched::GATHER) { if (has_next) PG8_GOFF(ui + 1, ngA0, ngA1); else { ngA0[0] = gA0[0]; ngA0[1] = gA0[1]; ngA1[0] = gA1[0]; ngA1[1] = gA1[1]; } }
#pragma unroll 1
        for (int t = 0; t < nt; t += 2) {
            const bool last = (t == nt - 2);
            const char* a1 = cA + (size_t)(t + 1) * kstep;
            const char* a2 = last ? nA : cA + (size_t)(t + 2) * kstep; const char* b2 = last ? nB : cB + (size_t)(t + 2) * kstep;
            const char* a3 = a2 + kstep; const char* b3 = b2 + kstep;
            if (last && has_next) S.a_ready(nxt);
            unsigned xA0[2], xA1[2];
            xA0[0] = last ? ngA0[0] : gA0[0]; xA0[1] = last ? ngA0[1] : gA0[1]; xA1[0] = last ? ngA1[0] : gA1[0]; xA1[1] = last ? ngA1[1] : gA1[1];
            if constexpr (SP2) {
            PG8_LDB(B0, 0, 0); PG8_LDB(B1, 0, 1); PG8_SCHED; PG8_LDA(At, 0, 0); PG8_STAGE_A1(PG8_SA(1, 1), a1, gA1);
            PG8_WAIT_V(8); PG8_WAIT_L(0); PG8_BAR; PG8_MMA(0, 0, At, B0); PG8_MMA(0, 1, At, B1); PG8_BAR; PG8_SCHED;
            PG8_LDA(At, 0, 1); PG8_STAGE(PG8_SB(0, 0), b2, voffB); PG8_STAGE(PG8_SB(0, 1), b2 + hstep, voffB); PG8_STAGE_A0(PG8_SA(0, 0), a2, xA0);
            PG8_WAIT_V(8); PG8_WAIT_L(0); PG8_BAR; PG8_MMA(1, 0, At, B0); PG8_MMA(1, 1, At, B1); PG8_BAR; PG8_SCHED;
            PG8_LDB(B0, 1, 0); PG8_LDB(B1, 1, 1); PG8_SCHED; PG8_LDA(At, 1, 0); PG8_STAGE_A1(PG8_SA(0, 1), a2, xA1);
            PG8_WAIT_V(8); PG8_WAIT_L(0); PG8_BAR; PG8_MMA(0, 0, At, B0); PG8_MMA(0, 1, At, B1); PG8_BAR; PG8_SCHED;
            PG8_LDA(At, 1, 1); PG8_STAGE(PG8_SB(1, 0), b3, voffB); PG8_STAGE(PG8_SB(1, 1), b3 + hstep, voffB); PG8_STAGE_A0(PG8_SA(1, 0), a3, xA0);
            PG8_WAIT_V(8); PG8_WAIT_L(0); PG8_BAR; PG8_MMA(1, 0, At, B0); PG8_MMA(1, 1, At, B1); PG8_BAR; PG8_SCHED;
            } else {
            PG8_LDB(B0, 0, 0); PG8_SCHED; PG8_LDA(At, 0, 0); PG8_STAGE(PG8_SA(1, 1), a1 + hstep, voffA);
            PG8_WAIT_L(8); PG8_BAR; PG8_WAIT_L(0); PG8_MMA(0, 0, At, B0); PG8_BAR; PG8_SCHED;
            PG8_LDB(B1, 0, 1); PG8_STAGE(PG8_SB(0, 0), b2, voffB);
            PG8_BAR; PG8_WAIT_L(0); PG8_MMA(0, 1, At, B1); PG8_BAR;
            PG8_LDA(At, 0, 1); PG8_STAGE(PG8_SA(0, 0), a2, voffA);
            PG8_BAR; PG8_WAIT_L(0); PG8_MMA(1, 0, At, B0); PG8_BAR; PG8_SCHED;
            PG8_STAGE(PG8_SB(0, 1), b2 + hstep, voffB);
            PG8_WAIT_V(6); PG8_BAR; PG8_MMA(1, 1, At, B1); PG8_BAR;
            PG8_LDB(B0, 1, 0); PG8_SCHED; PG8_LDA(At, 1, 0); PG8_STAGE(PG8_SA(0, 1), a2 + hstep, voffA);
            PG8_WAIT_L(8); PG8_BAR; PG8_WAIT_L(0); PG8_MMA(0, 0, At, B0); PG8_BAR; PG8_SCHED;
            PG8_LDB(B1, 1, 1); PG8_STAGE(PG8_SB(1, 0), b3, voffB);
            PG8_BAR; PG8_WAIT_L(0); PG8_MMA(0, 1, At, B1); PG8_BAR;
            PG8_LDA(At, 1, 1); PG8_STAGE(PG8_SA(1, 0), a3, voffA);
            PG8_BAR; PG8_WAIT_L(0); PG8_MMA(1, 0, At, B0); PG8_BAR; PG8_SCHED;
            PG8_STAGE(PG8_SB(1, 1), b3 + hstep, voffB);
            PG8_WAIT_V(6); PG8_BAR; PG8_MMA(1, 1, At, B1); PG8_BAR;
            }
        }
        if constexpr (FP8) asm volatile("s_nop 15\n\ts_nop 15" ::: "memory");
        if constexpr (ALIGN_EPI) { if (wr == 0) PG8_BAR; }
        if constexpr (!Epi::AFTER_DRAIN) { E(acc, cur, wr, wc, fr, fq); S.done(cur); }
        if (!has_next) break;
#pragma unroll
        for (int a = 0; a < 2; ++a)
#pragma unroll
            for (int b = 0; b < 2; ++b)
#pragma unroll
                for (int m = 0; m < 4; ++m)
#pragma unroll
                    for (int n = 0; n < 2; ++n) acc[a][b][m][n] = (f32x4){0.f, 0.f, 0.f, 0.f};
        cur = nxt; cA = nA; cB = nB; ++ui;
        if constexpr (Sched::GATHER) { gA0[0] = ngA0[0]; gA0[1] = ngA0[1]; gA1[0] = ngA1[0]; gA1[1] = ngA1[1]; }
        if constexpr (ALIGN_EPI) { if (wr == 1) PG8_BAR; }
    }
    PG8_WAIT_V(0);
    if constexpr (!ALIGN_EPI) { if (wr == 0) PG8_BAR; }
    PG8_BAR;
    if constexpr (Epi::AFTER_DRAIN) { E.fused(acc, cur, wr, wc, fr, fq, lds, wid, lane); S.done(cur); }
#undef PG8_SA
#undef PG8_SB
#undef PG8_STAGE
#undef PG8_STAGE_A0
#undef PG8_STAGE_A1
#undef PG8_GOFF
#undef PG8_LDA
#undef PG8_LDB
#undef PG8_MMA
#undef PG8_CAT8
#undef PG8_WAIT_V
#undef PG8_WAIT_L
#undef PG8_BAR
#undef PG8_SCHED
}
}

namespace pg8 {
__device__ __forceinline__ void gst16(void* p, u32x4 v) {
    *(u32x4*)p = v;
}
typedef unsigned u32x2e_t __attribute__((ext_vector_type(2)));
__device__ __forceinline__ void gst8(void* p, u32x2e_t v) {
    *(u32x2e_t*)p = v;
}
__device__ __forceinline__ void gst_pair(unsigned char* slot_ra, unsigned char* slot_rb, u32x2e_t pa, u32x2e_t pb, bool odd) {
    const unsigned sx = odd ? pa.x : pb.x, sy = odd ? pa.y : pb.y;
    const unsigned rx = (unsigned)__shfl_xor((int)sx, 16), ry = (unsigned)__shfl_xor((int)sy, 16);
    u32x4 out; out.x = odd ? rx : pa.x; out.y = odd ? ry : pa.y; out.z = odd ? pb.x : rx; out.w = odd ? pb.y : ry;
    gst16(odd ? slot_rb - 8 : slot_ra, out);
}
}
namespace pg8 {
__device__ __forceinline__ void map_tile(int wgid, int nM, int nN, int& pm, int& pn) {
    const int nwg = nM * nN;
    { const int q = nwg / NXCD, r = nwg % NXCD, xcd = wgid % NXCD, off = wgid / NXCD; wgid = (xcd < r ? xcd * (q + 1) : r * (q + 1) + (xcd - r) * q) + off; }
    const int nig = WGM * nN, gid = wgid / nig, fm = gid * WGM, gsz = (nM - fm) < WGM ? (nM - fm) : WGM;
    pm = fm + ((wgid % nig) % gsz); pn = (wgid % nig) / gsz;
}
struct DenseOrder2 {
    static constexpr bool GATHER = false;
    __device__ __forceinline__ int arow(int, int) const { return 0; }
    int nM1, nN1, nM2, nN2, pm0_2, G, c;
    __device__ __forceinline__ bool next(int i, Unit& u) const {
        const int L = i * G + c; const int n1 = nM1 * nN1, n2 = nM2 * nN2;
        if (L >= n1 + n2) return false;
        if (L < n1) map_tile(L, nM1, nN1, u.pm, u.pn); else { map_tile(L - n1, nM2, nN2, u.pm, u.pn); u.pm += pm0_2; }
        return true;
    }
    __device__ __forceinline__ void a_ready(const Unit&) const {}
    __device__ __forceinline__ void done(const Unit&) const {}
};
struct GroupedOrder {
    static constexpr bool GATHER = false;
    __device__ __forceinline__ int arow(int, int) const { return 0; }
    int te, NT, G, c;
    __device__ __forceinline__ bool next(int i, Unit& u) const {
        const int L = i * G + c; const int nM = 16 * te;
        if (L >= nM * NT) return false;
        int pmv, pnv; map_tile(L, nM, NT, pmv, pnv);
        const int e = pmv / te; u.pm = e * 18 + (pmv - e * te); u.pn = e * NT + pnv; return true;
    }
    __device__ __forceinline__ void a_ready(const Unit&) const {}
    __device__ __forceinline__ void done(const Unit&) const {}
};
struct GatherOrder : GroupedOrder {
    static constexpr bool GATHER = true;
    const PG8_LAS int* ridx;
    __device__ __forceinline__ int arow(int ui, int r) const { return ridx[ui * 256 + r]; }
};
struct EpiProj {
    static constexpr bool PERM = true, AFTER_DRAIN = false;
    bf16_t* O;
    __device__ __forceinline__ void operator()(const f32x4 (&acc)[2][2][4][2], const Unit& u, int wr, int wc, int fr, int fq) const {
        const int row0 = u.pm * BM + wr * 64 + fr, col0 = u.pn * BM + wc * 32 + 8 * fq;
#pragma unroll
        for (int ai = 0; ai < 2; ++ai)
#pragma unroll
            for (int m = 0; m < 4; ++m) { bf16_t* rowp = O + (size_t)(row0 + ai * HALF + m * 16) * NP + col0;
#pragma unroll
                for (int bj = 0; bj < 2; ++bj) { const f32x4 v0 = acc[ai][bj][m][0], v1 = acc[ai][bj][m][1];
                    u32x4 w; w.x = cvt_pk_bf16(v0[0], v0[1]); w.y = cvt_pk_bf16(v0[2], v0[3]); w.z = cvt_pk_bf16(v1[0], v1[1]); w.w = cvt_pk_bf16(v1[2], v1[3]);
                    gst16(rowp + bj * HALF, w); } }
    }
};
struct EpiY {
    static constexpr bool PERM = true, AFTER_DRAIN = false;
    bf16_t* O;
    __device__ __forceinline__ void operator()(const f32x4 (&acc)[2][2][4][2], const Unit& u, int wr, int wc, int fr, int fq) const {
        const int row0 = u.pm * BM + wr * 64 + fr, col0 = u.pn * BM + wc * 32 + 8 * fq;
#pragma unroll
        for (int ai = 0; ai < 2; ++ai)
#pragma unroll
            for (int m = 0; m < 4; ++m) { bf16_t* rowp = O + (size_t)(row0 + ai * HALF + m * 16) * D_ + col0;
#pragma unroll
                for (int bj = 0; bj < 2; ++bj) { const f32x4 v0 = acc[ai][bj][m][0], v1 = acc[ai][bj][m][1];
                    u32x4 w; w.x = cvt_pk_bf16(v0[0], v0[1]); w.y = cvt_pk_bf16(v0[2], v0[3]); w.z = cvt_pk_bf16(v1[0], v1[1]); w.w = cvt_pk_bf16(v1[2], v1[3]);
                    gst16(rowp + bj * HALF, w); } }
    }
};
__device__ __forceinline__ float silu_f(float x) { return x * __builtin_amdgcn_rcpf(1.f + __builtin_amdgcn_exp2f(-1.4426950408889634f * x)); }
__device__ __forceinline__ f32x4 silu_mul4(const f32x4 g, const f32x4 u) {
    constexpr float KA = -1.4426950408889634f * W8_INV, KC = 1.f / (W8_INV * W8_INV);
    const f32x4 arg = g * KA;
    const f32x4 e = (f32x4){__builtin_amdgcn_exp2f(arg[0]), __builtin_amdgcn_exp2f(arg[1]), __builtin_amdgcn_exp2f(arg[2]), __builtin_amdgcn_exp2f(arg[3])};
    const f32x4 d = e * KC + KC;
    const f32x4 r = (f32x4){__builtin_amdgcn_rcpf(d[0]), __builtin_amdgcn_rcpf(d[1]), __builtin_amdgcn_rcpf(d[2]), __builtin_amdgcn_rcpf(d[3])};
    return (g * u) * r;
}
struct EpiUp8 {
    static constexpr bool PERM = true, AFTER_DRAIN = false;
    unsigned char* H;
    __device__ __forceinline__ void operator()(const f32x4 (&acc)[2][2][4][2], const Unit& u, int wr, int wc, int fr, int fq) const {
        const int row0 = u.pm * BM + wr * 64 + fr, col0 = (u.pn & 7) * HALF + wc * 32 + 8 * fq;
        const bool odd = fq & 1;
#pragma unroll
        for (int ai = 0; ai < 2; ++ai)
#pragma unroll
            for (int mp = 0; mp < 4; mp += 2) {
                u32x2e_t pc[2];
#pragma unroll
                for (int k = 0; k < 2; ++k) { const int m = mp + k;
                    const f32x4 o0 = silu_mul4(acc[ai][0][m][0], acc[ai][1][m][0]), o1 = silu_mul4(acc[ai][0][m][1], acc[ai][1][m][1]);
                    pc[k] = (u32x2e_t){pk4_fp8(o0[0], o0[1], o0[2], o0[3]), pk4_fp8(o1[0], o1[1], o1[2], o1[3])}; }
                unsigned char* ra = H + (size_t)(row0 + ai * HALF + mp * 16) * D_ + col0;
                gst_pair(ra, ra + (size_t)16 * D_, pc[0], pc[1], odd); }
    }
};
struct EpiDown {
    static constexpr bool PERM = true, AFTER_DRAIN = false;
    unsigned char* Y; const float* gate; float wscale;
    __device__ __forceinline__ void operator()(const f32x4 (&acc)[2][2][4][2], const Unit& u, int wr, int wc, int fr, int fq) const {
        const int row0 = u.pm * BM + wr * 64 + fr, col0 = (u.pn & 3) * BM + wc * 32 + 8 * fq;
        typedef unsigned u32x2_t __attribute__((ext_vector_type(2)));
        const bool odd = fq & 1;
#pragma unroll
        for (int ai = 0; ai < 2; ++ai)
#pragma unroll
            for (int mp = 0; mp < 4; mp += 2) { const int row = row0 + ai * HALF + mp * 16; const float ga = gate[row] * wscale, gb = gate[row + 16] * wscale; unsigned char* rowp = Y + (size_t)row * D_ + col0;
#pragma unroll
                for (int bj = 0; bj < 2; ++bj) {
                    const f32x4 a0 = acc[ai][bj][mp][0] * ga, a1 = acc[ai][bj][mp][1] * ga, b0 = acc[ai][bj][mp + 1][0] * gb, b1 = acc[ai][bj][mp + 1][1] * gb;
                    gst_pair(rowp + bj * HALF, rowp + (size_t)16 * D_ + bj * HALF, (u32x2e_t){pk4_fp8(a0[0], a0[1], a0[2], a0[3]), pk4_fp8(a1[0], a1[1], a1[2], a1[3])},
                             (u32x2e_t){pk4_fp8(b0[0], b0[1], b0[2], b0[3]), pk4_fp8(b1[0], b1[1], b1[2], b1[3])}, odd); } }
    }
};
}

constexpr size_t WB_IN = 0, WB_OUT = 6 * MiB, WB_13 = 8 * MiB, WB_2 = 40 * MiB;
__device__ __forceinline__ unsigned cvtpk_w(float lo, float hi) { unsigned r; asm volatile("v_cvt_pk_bf16_f32 %0, %1, %2" : "=v"(r) : "v"(lo), "v"(hi)); return r; }
__device__ __forceinline__ void transpose_item(const float* W, int N, int srccol0, bf16* WT, int kb, LAS float* scr, int lane) {
    const int k0 = 64 * kb;
    float tmp[32];
    const float* src = W + (size_t)(k0 + (lane >> 5)) * N + (srccol0 < 0 ? 0 : srccol0) + (lane & 31);
#pragma unroll
    for (int i = 0; i < 32; ++i) tmp[i] = src[(size_t)(2 * i) * N];
#pragma unroll
    for (int i = 0; i < 32; ++i) scr[(2 * i + (lane >> 5)) * 33 + (lane & 31)] = (srccol0 < 0) ? 0.f : tmp[i];
    asm volatile("s_waitcnt lgkmcnt(0)" ::: "memory");
    const int c = lane & 7;
#pragma unroll
    for (int j = 0; j < 4; ++j) { const int n = (lane >> 3) + 8 * j; const LAS float* s = scr + (8 * c) * 33 + n;
        v4u o; o.x = cvtpk_w(s[0 * 33], s[1 * 33]); o.y = cvtpk_w(s[2 * 33], s[3 * 33]); o.z = cvtpk_w(s[4 * 33], s[5 * 33]); o.w = cvtpk_w(s[6 * 33], s[7 * 33]);
        *(v4u*)(WT + (size_t)n * D_ + k0 + 8 * c) = o; }
    asm volatile("s_waitcnt lgkmcnt(0)" ::: "memory");
}
__device__ __forceinline__ void transpose_item_fp8(const float* W, int N, int srccol0, unsigned char* WT8, int kb, LAS float* scr, int lane) {
    const int k0 = 64 * kb;
    float tmp[32];
    const float* src = W + (size_t)(k0 + (lane >> 5)) * N + srccol0 + (lane & 31);
#pragma unroll
    for (int i = 0; i < 32; ++i) tmp[i] = src[(size_t)(2 * i) * N];
#pragma unroll
    for (int i = 0; i < 32; ++i) scr[(2 * i + (lane >> 5)) * 33 + (lane & 31)] = tmp[i] * W8_SCALE;
    asm volatile("s_waitcnt lgkmcnt(0)" ::: "memory");
    const int n = lane >> 1, hf = lane & 1;
    const LAS float* sp = scr + (32 * hf) * 33 + n;
    v4u o0, o1;
    o0.x = pk4_fp8(sp[0 * 33], sp[1 * 33], sp[2 * 33], sp[3 * 33]);     o0.y = pk4_fp8(sp[4 * 33], sp[5 * 33], sp[6 * 33], sp[7 * 33]);
    o0.z = pk4_fp8(sp[8 * 33], sp[9 * 33], sp[10 * 33], sp[11 * 33]);   o0.w = pk4_fp8(sp[12 * 33], sp[13 * 33], sp[14 * 33], sp[15 * 33]);
    o1.x = pk4_fp8(sp[16 * 33], sp[17 * 33], sp[18 * 33], sp[19 * 33]); o1.y = pk4_fp8(sp[20 * 33], sp[21 * 33], sp[22 * 33], sp[23 * 33]);
    o1.z = pk4_fp8(sp[24 * 33], sp[25 * 33], sp[26 * 33], sp[27 * 33]); o1.w = pk4_fp8(sp[28 * 33], sp[29 * 33], sp[30 * 33], sp[31 * 33]);
    unsigned char* dst = WT8 + (size_t)n * D_ + k0 + 32 * hf;
    *(v4u*)dst = o0; *(v4u*)(dst + 16) = o1;
    asm volatile("s_waitcnt lgkmcnt(0)" ::: "memory");
}
constexpr int WP_NRB = 96 + 32 + 1024 + 512, WP_NIT = 16 * WP_NRB;
constexpr int WP_R0 = 3600, WP_R1 = 15600, WP_R2 = 19600, WP_R3 = 23000;
__device__ __forceinline__ void p_wprep(const Ctx& a, LAS unsigned char* lds, int layer, int tid, int it_lo, int it_hi, int worker, int nworkers) {
    const int lane = tid & 63, wave = __builtin_amdgcn_readfirstlane(tid >> 6);
    LAS float* scr = (LAS float*)(lds + wave * 16384);
    const int gw = worker * NWAVES + wave, NGW = nworkers * NWAVES;
    unsigned char* wb = a.ws() + WS_WB + (size_t)layer * WB_LAYER;
    const float* w_in = a.in(8) + (size_t)layer * D_ * DIN; const float* w_out = a.in(20) + (size_t)layer * D_ * D_;
    const float* w1 = a.in(22) + (size_t)layer * NE * D_ * D_; const float* w3 = a.in(23) + (size_t)layer * NE * D_ * D_; const float* w2 = a.in(24) + (size_t)layer * NE * D_ * D_;
    constexpr int NRB = WP_NRB;
    for (int it = it_lo + gw; it < it_hi; it += NGW) {
        const int kb = it / NRB, rb = it % NRB;
        if (rb < 96) transpose_item(w_in, DIN, ref_col(32 * rb), (bf16*)(wb + WB_IN) + (size_t)(32 * rb) * D_, kb, scr, lane);
        else if (rb < 128) transpose_item(w_out, D_, 32 * (rb - 96), (bf16*)(wb + WB_OUT) + (size_t)(32 * (rb - 96)) * D_, kb, scr, lane);
        else if (rb < 1152) { const int q = rb - 128, e = q >> 6, w = q & 63, tile = w >> 3, within = w & 7;
            transpose_item_fp8((within < 4 ? w1 : w3) + (size_t)e * D_ * D_, D_, 128 * tile + 32 * (within & 3), wb + WB_13 + ((size_t)e * 2048 + 32 * w) * D_, kb, scr, lane); }
        else { const int q = rb - 1152, e = q >> 5, w = q & 31;
            transpose_item_fp8(w2 + (size_t)e * D_ * D_, D_, 32 * w, wb + WB_2 + ((size_t)e * 1024 + 32 * w) * D_, kb, scr, lane); }
    }
}
__device__ __forceinline__ void wprep_in_slack(const Ctx& a, LAS unsigned char* lds, int nunits, int lo, int hi) {
    const int G = gridDim.x, rem = nunits % 256;
    if (G != 256 || rem == 0 || (int)blockIdx.x < rem) return;
    __syncthreads();
    p_wprep(a, lds, 1, otid(), lo, hi, (int)blockIdx.x - rem, 256 - rem);
}
#ifndef PG8_SP2
#define PG8_SP2 true
#endif
#ifndef PG8_ALIGN
#define PG8_ALIGN true
#endif
__device__ __forceinline__ void p_gemm_in_fast(const Ctx& a, LAS unsigned char* lds, int layer) {
    unsigned char* ws = a.ws();
    pg8::Gemm g{(const bf16*)(ws + WS_HN), (const bf16*)(ws + WS_WB + (size_t)layer * WB_LAYER + WB_IN), MT, NP, D_};
    pg8::DenseOrder2 S{(layer == 0) ? MT / 256 : NLAT / 256, NP / 256, (layer == 0) ? 0 : NCTX / 256, 4, NLAT / 256, (int)gridDim.x, (int)blockIdx.x};
    pg8::EpiProj E{(bf16*)(ws + WS_PROJ)};
    pg8::gemm_phase<pg8::EpiProj, pg8::DenseOrder2, PG8_ALIGN, PG8_SP2>(lds, g, S, E);
    if (layer == 0) wprep_in_slack(a, lds, (MT / 256) * (NP / 256), 0, WP_R0);
}
__device__ __forceinline__ void p_gemm_out_fast(const Ctx& a, LAS unsigned char* lds, int layer) {
    unsigned char* ws = a.ws();
    pg8::Gemm g{(const bf16*)(ws + WS_YMIX), (const bf16*)(ws + WS_WB + (size_t)layer * WB_LAYER + WB_OUT), MT, D_, D_};
    pg8::DenseOrder2 S{(layer == 0) ? MT / 256 : NLAT / 256, D_ / 256, 0, 1, 0, (int)gridDim.x, (int)blockIdx.x};
    pg8::EpiY E{(bf16*)(ws + WS_YO)};
    pg8::gemm_phase<pg8::EpiY, pg8::DenseOrder2, PG8_ALIGN, PG8_SP2>(lds, g, S, E);
    if (layer == 0) wprep_in_slack(a, lds, (MT / 256) * (D_ / 256), WP_R0, WP_R1);
}
constexpr int RIDX_OFF = RING_BYTES + 1024;
__device__ __forceinline__ void p_gemm_up_fast(const Ctx& a, LAS unsigned char* lds, int layer) {
    unsigned char* ws = a.ws();
    pg8::Gemm g{(const bf16*)(ws + WS_HN), (const bf16*)(ws + WS_WB + (size_t)layer * WB_LAYER + WB_13), MT, NE * 2048, D_ / 2};
    pg8::GatherOrder S; S.te = (layer == 0) ? 18 : 16; S.NT = 8; S.G = (int)gridDim.x; S.c = (int)blockIdx.x; S.ridx = (const LAS int*)(lds + RIDX_OFF);
    {
        const int* IDX = (const int*)(ws + WS_IDX); const int tid = otid();
        pg8::Unit u;
        int rv[12];
#pragma unroll
        for (int i = 0; i < 12; ++i) { const bool ok = S.next(i, u); rv[i] = (ok && tid < 256) ? IDX[u.pm * 256 + tid] : -1; }
#pragma unroll
        for (int i = 0; i < 12; ++i) if (rv[i] >= 0) ((LAS int*)(lds + RIDX_OFF))[i * 256 + tid] = rv[i];
        __syncthreads();
    }
    pg8::EpiUp8 E{ws + WS_HID};
    pg8::gemm_phase<pg8::EpiUp8, pg8::GatherOrder, PG8_ALIGN, PG8_SP2, true>(lds, g, S, E);
}
__device__ __forceinline__ void p_gemm_down_fast(const Ctx& a, LAS unsigned char* lds, int layer) {
    unsigned char* ws = a.ws();
    pg8::Gemm g{(const bf16*)(ws + WS_HID), (const bf16*)(ws + WS_WB + (size_t)layer * WB_LAYER + WB_2), NE * SLOTS, NE * 1024, D_ / 2};
    pg8::GroupedOrder S{(layer == 0) ? 18 : 16, 4, (int)gridDim.x, (int)blockIdx.x};
    pg8::EpiDown E{ws + WS_Y2, (const float*)(ws + WS_GATE), W8_INV * Y8_SCALE};
    pg8::gemm_phase<pg8::EpiDown, pg8::GroupedOrder, PG8_ALIGN, PG8_SP2, true>(lds, g, S, E);
    if (layer == 0) wprep_in_slack(a, lds, 16 * 18 * 4, WP_R1, WP_R2);
}

__global__ void __launch_bounds__(NWAVES * 64, 2) mk_fwd(Args args) {
    extern __shared__ __attribute__((aligned(16))) unsigned char lds_raw[];
    LAS unsigned char* lds = (LAS unsigned char*)lds_raw;
    const int tid = threadIdx.x;
    for (int u = tid; u < (LDS_BYTES - LDSCTL_OFF) / 4; u += NWAVES * 64) ((LAS unsigned*)(lds + LDSCTL_OFF))[u] = 0u;
    __syncthreads();
    {
        LAS unsigned long long* tabw = (LAS unsigned long long*)(lds + LDSCTL_OFF + 64);
        if (tid < 26) tabw[tid] = (unsigned long long)args.in[tid];
        if (tid == 26) tabw[26] = (unsigned long long)args.out;
        if (tid == 27) tabw[27] = (unsigned long long)args.ws;
    }
    __syncthreads();
    Ctx ctx; ctx.tab = (const LAS unsigned long long*)(lds + LDSCTL_OFF + 64);
    if (N_LAUNCHES == 1) (void)xcd_barrier_post((unsigned*)(args.ws + WS_CTL) + CW_BAR, (volatile LAS unsigned*)(lds + MISC_OFF) + 8);
    const int lo = args.ph_lo, hi = args.ph_hi;
#define IN(k) (lo <= (k) && (k) < hi)
#if defined(REPP)
#define REPS(k) for (int rep_ = 0; rep_ < (((k) == REPP) ? NREP : 1); ++rep_)
#else
#define REPS(k)
#endif
#define SEAM(k) do { if (IN(k) && IN((k) + 1)) { XcdBarrier b_; b_.bar = (unsigned*)(ctx.ws() + WS_CTL) + CW_BAR; b_.x = xb_xcc_id(); b_.st = (volatile LAS unsigned*)(lds + MISC_OFF) + 8; xcd_barrier(b_); } } while (0)
    if (IN(0)) REPS(0) { __syncthreads(); p_mod(ctx, lds, otid()); __syncthreads(); p_wprep(ctx, lds, 0, otid(), 0, WP_NIT, (int)blockIdx.x, (int)gridDim.x); }
    SEAM(0);
    for (int l = 0; l < 2; ++l) {
        const int pb = 1 + 9 * l;
        if (IN(pb + 0)) REPS(pb + 0) { __syncthreads(); if (l == 0) p_norm1<0>(ctx, otid()); else p_norm1<1>(ctx, otid()); if (l == 1) { __syncthreads(); p_wprep(ctx, lds, 1, otid(), (gridDim.x == 256) ? WP_R3 : 0, WP_NIT, (int)blockIdx.x, (int)gridDim.x); } }
        SEAM(pb + 0);
        if (IN(pb + 1)) REPS(pb + 1) {
            __syncthreads(); p_gemm_in_fast(ctx, lds, l);
        }
        SEAM(pb + 1);
        if (IN(pb + 2)) REPS(pb + 2) { p_mix(ctx, lds, l, otid()); if (l == 0 && gridDim.x == 256 && blockIdx.x >= 128) { __syncthreads(); p_wprep(ctx, lds, 1, otid(), WP_R2, WP_R3, (int)blockIdx.x - 128, 128); } }
        SEAM(pb + 2);
        if (IN(pb + 3)) REPS(pb + 3) { p_glaout(ctx, l, otid()); }
        SEAM(pb + 3);
        if (IN(pb + 4)) REPS(pb + 4) {
            __syncthreads(); p_gemm_out_fast(ctx, lds, l);
        }
        SEAM(pb + 4);
        if (IN(pb + 5)) REPS(pb + 5) { __syncthreads(); if (l == 0) p_norm2<0>(ctx, lds, otid()); else p_norm2<1>(ctx, lds, otid()); }
        SEAM(pb + 5);
        if (IN(pb + 6)) REPS(pb + 6) { __syncthreads(); p_topk(ctx, lds, l, otid()); }
        SEAM(pb + 6);
        if (IN(pb + 7)) REPS(pb + 7) {
            __syncthreads(); p_gemm_up_fast(ctx, lds, l);
        }
        SEAM(pb + 7);
        if (IN(pb + 8)) REPS(pb + 8) {
            __syncthreads(); p_gemm_down_fast(ctx, lds, l);
        }
        SEAM(pb + 8);
    }
    if (IN(19)) { p_norm1<2>(ctx, otid()); }
#undef IN
#undef SEAM
}

extern "C" void kernel_launch(void* const* d_in, const int* in_sizes, int n_in, void* d_out, int out_size, void* d_ws, size_t ws_size, hipStream_t stream) {
    static int grid = 0;
    if (grid == 0) {
        if (n_in != 26 || in_sizes[0] != NLAT * D_ || out_size != NLAT * D_ || ws_size < WS_END) {
            fprintf(stderr, "kernel_launch: unexpected shapes: n_in %d in0 %d out %d ws %zu (need %zu); nothing launched\n", n_in, n_in > 0 ? in_sizes[0] : -1, out_size, ws_size, (size_t)WS_END);
            grid = -1; return;
        }
        int dev = 0, cus = 0, per_cu = 0;
        if (hipGetDevice(&dev) != hipSuccess || hipDeviceGetAttribute(&cus, hipDeviceAttributeMultiprocessorCount, dev) != hipSuccess) { grid = -1; return; }
        if (hipFuncSetAttribute((const void*)mk_fwd, hipFuncAttributeMaxDynamicSharedMemorySize, LDS_BYTES) != hipSuccess) { fprintf(stderr, "kernel_launch: hipFuncSetAttribute failed\n"); grid = -1; return; }
        if (hipOccupancyMaxActiveBlocksPerMultiprocessor(&per_cu, (const void*)mk_fwd, NWAVES * 64, LDS_BYTES) != hipSuccess || per_cu < 1) {
            fprintf(stderr, "kernel_launch: occupancy query reports %d blocks per CU; nothing launched\n", per_cu); (void)hipGetLastError(); grid = -1; return;
        }
        grid = cus;
    }
    if (grid < 0) return;
    if (hipMemsetAsync((char*)d_ws + WS_CTL, 0, CTL_ZERO_BYTES, stream) != hipSuccess) return;
    Args a{};
    for (int i = 0; i < 26; ++i) a.in[i] = (const float*)d_in[i];
    a.out = (float*)d_out; a.ws = (unsigned char*)d_ws;
    for (int li = 0; li < N_LAUNCHES; ++li) {
        if (N_LAUNCHES == 1) { a.ph_lo = 0; a.ph_hi = NPHASES; } else { a.ph_lo = li; a.ph_hi = li + 1; }
        a.li = li;
        hipLaunchKernelGGL(mk_fwd, dim3(grid), dim3(NWAVES * 64), LDS_BYTES, stream, a);
        const hipError_t le = hipPeekAtLastError();
        if (le != hipSuccess) { fprintf(stderr, "kernel_launch: launch %d failed: %s\n", li, hipGetErrorName(le)); break; }
    }
}
```
